# Optimizing an MI355X kernel written in HIP

```python
import math
import jax
import jax.numpy as jnp
from jax import lax
import numpy as np

D_MODEL = 1024
BATCH = 8
SEQ = 2048
DEPTH = 1

CTX_LEN = 256
GRID_W = 64
MIX_WIDTH = D_MODEL
HY_WIDTH = MIX_WIDTH // 2
HY_ORDER = 2
HY_EMB_BANDS = 16
HY_EMB_DIM = 1 + 2 * HY_EMB_BANDS
HY_FILTER_WIDTH = 64
HY_FAST_DECAY = 0.3
HY_SLOW_DECAY = 1.5
HY_TARGET = 1e-2
HY_FILTER_INIT = 0.01
RET_WIDTH = MIX_WIDTH - HY_WIDTH
RET_HEADS = 4
RET_QK_DIM = 64
RET_V_DIM = RET_WIDTH // RET_HEADS
RET_CHUNK = 128
ROPE_BASE = 10000.0
D_FF = 2816
EPS = 1e-6

HY_COLS = (HY_ORDER + 1) * HY_WIDTH
RET_QK_WIDTH = RET_HEADS * RET_QK_DIM
Q_OFF = HY_COLS
K_OFF = Q_OFF + RET_QK_WIDTH
V_OFF = K_OFF + RET_QK_WIDTH
G_OFF = V_OFF + RET_WIDTH
IN_COLS = G_OFF + RET_WIDTH

kernel_name = 'hyena_retention_hybrid_dit'


def rms_norm(x, gain):
    xf = x.astype(jnp.float32)
    y = xf * lax.rsqrt(jnp.mean(xf * xf, axis=-1, keepdims=True) + EPS)
    return (y * gain.astype(jnp.float32)).astype(x.dtype)


def modulate(h, shift, scale):
    return h * (1.0 + scale) + shift


def depthwise_conv3(x, w, b):
    seq = x.shape[1]
    xp = jnp.pad(x, ((0, 0), (1, 1), (0, 0)))
    return xp[:, :seq] * w[0] + xp[:, 1:seq + 1] * w[1] + xp[:, 2:] * w[2] + b


def hyena_filters(seq, w1, b1, f1, w2, b2, f2, w3):
    pos = jnp.arange(seq, dtype=jnp.float32)[:, None]
    t = jnp.linspace(0.0, 1.0, seq, dtype=jnp.float32)[:, None]
    bands = jnp.linspace(1e-4, HY_EMB_BANDS - 1, HY_EMB_BANDS, dtype=jnp.float32)[None, :]
    ang = 2.0 * math.pi * pos * bands / seq
    z = jnp.concatenate([t, jnp.cos(ang), -jnp.sin(ang)], axis=-1)
    hid = jnp.sin(f1 * (z @ w1 + b1))
    hid = jnp.sin(f2 * (hid @ w2 + b2))
    filt = (hid @ w3).reshape(seq, 2, HY_ORDER, HY_WIDTH)
    max_decay = math.log(HY_TARGET) / HY_FAST_DECAY
    min_decay = math.log(HY_TARGET) / HY_SLOW_DECAY
    deltas = jnp.linspace(min_decay, max_decay, HY_WIDTH, dtype=jnp.float32)
    window = jnp.exp(-t * jnp.abs(deltas)[None, :])
    return filt * window[:, None, None, :]


def bidirectional_fftconv(u, k_fwd, k_bwd, skip):
    seq = u.shape[1]
    kern = jnp.concatenate([k_fwd, jnp.zeros_like(k_fwd[:1]), k_bwd[:0:-1]], axis=0)
    k_f = jnp.fft.rfft(kern.astype(jnp.float32), n=2 * seq, axis=0)
    u32 = u.astype(jnp.float32)
    u_f = jnp.fft.rfft(u32, n=2 * seq, axis=1)
    y = jnp.fft.irfft(u_f * k_f[None], n=2 * seq, axis=1)[:, :seq]
    return (y + u32 * skip.astype(jnp.float32)).astype(u.dtype)


def hyena_mixer(z, p):
    z = depthwise_conv3(z, p['hy_conv_w'], p['hy_conv_b'])
    v, *gates = jnp.split(z, HY_ORDER + 1, axis=-1)
    filt = hyena_filters(z.shape[1], p['hy_w1'], p['hy_b1'], p['hy_f1'],
                         p['hy_w2'], p['hy_b2'], p['hy_f2'], p['hy_w3'])
    y = v
    for o in range(HY_ORDER):
        y = gates[o] * bidirectional_fftconv(y, filt[:, 0, o], filt[:, 1, o], p['hy_bias'][o])
    return y


def split_heads(t):
    b, seq, _ = t.shape
    return t.reshape(b, seq, RET_HEADS, -1).transpose(0, 2, 1, 3)


def rope_2d(x, row, col):
    half = x.shape[-1] // 2
    quarter = half // 2
    inv_freq = ROPE_BASE ** (-jnp.arange(quarter, dtype=jnp.float32) / quarter)
    ang = jnp.concatenate([row[:, None] * inv_freq, col[:, None] * inv_freq], axis=-1)
    cos, sin = jnp.cos(ang), jnp.sin(ang)
    x1, x2 = x[..., :half], x[..., half:]
    return jnp.concatenate([x1 * cos - x2 * sin, x1 * sin + x2 * cos], axis=-1)


def retention_chunkwise(q, k, v, log_gamma, s0, inclusive):
    b, h, seq, dk = q.shape
    dv = v.shape[-1]
    n_chunks = seq // RET_CHUNK
    qc = q.astype(jnp.float32).reshape(b, h, n_chunks, RET_CHUNK, dk)
    kc = k.astype(jnp.float32).reshape(b, h, n_chunks, RET_CHUNK, dk)
    vc = v.astype(jnp.float32).reshape(b, h, n_chunks, RET_CHUNK, dv)
    pos = jnp.arange(RET_CHUNK, dtype=jnp.float32)
    diff = pos[:, None] - pos[None, :]
    mask = (diff >= 0) if inclusive else (diff > 0)
    lg = log_gamma.astype(jnp.float32)[:, None]
    intra = jnp.where(mask[None], jnp.exp(lg[:, :, None] * jnp.maximum(diff, 0.0)[None]), 0.0)
    scores = jnp.einsum('bhnid,bhnjd->bhnij', qc, kc) * intra[None, :, None]
    o_intra = jnp.einsum('bhnij,bhnje->bhnie', scores, vc)
    k_w = jnp.exp(lg * (RET_CHUNK - 1.0 - pos))
    kv = jnp.einsum('bhnjd,hj,bhnje->nbhde', kc, k_w, vc)
    chunk_decay = jnp.exp(lg * RET_CHUNK)[None, :, :, None]

    def step(state, kv_n):
        return state * chunk_decay + kv_n, state

    _, s_prev = lax.scan(step, s0.astype(jnp.float32), kv)
    q_w = jnp.exp(lg * (pos + 1.0))
    o_cross = jnp.einsum('bhnid,nbhde,hi->bhnie', qc, s_prev, q_w)
    return (o_intra + o_cross).reshape(b, h, seq, dv)


def retention_final_state(k, v, log_gamma, reverse):
    seq = k.shape[2]
    pos = jnp.arange(seq, dtype=jnp.float32)
    steps = pos if reverse else (seq - 1.0 - pos)
    w = jnp.exp(log_gamma.astype(jnp.float32)[:, None] * steps[None, :])
    return jnp.einsum('bhld,hl,bhle->bhde', k.astype(jnp.float32), w, v.astype(jnp.float32))


def bidirectional_retention(q, k, v, lg_f, lg_b, s_f, s_b):
    o_f = retention_chunkwise(q, k, v, lg_f, s_f, True)
    o_b = retention_chunkwise(q[:, :, ::-1], k[:, :, ::-1], v[:, :, ::-1], lg_b, s_b, False)
    return o_f + o_b[:, :, ::-1]


def retention_output(o, g):
    of = o.astype(jnp.float32)
    of = of * lax.rsqrt(jnp.mean(of * of, axis=-1, keepdims=True) + EPS)
    b, h, seq, dv = o.shape
    of = of.transpose(0, 2, 1, 3).reshape(b, seq, h * dv)
    return (jax.nn.silu(g.astype(jnp.float32)) * of).astype(g.dtype)


def conv_ffn(h, p):
    a = depthwise_conv3(h @ p['ffn_w_up'], p['ffn_conv_w'], p['ffn_conv_b'])
    val, gate = jnp.split(a, 2, axis=-1)
    return (jax.nn.silu(gate) * val) @ p['ffn_w_down']


def trunk_layer(x, xc, c, c_ctx, p, ctx_out):
    mod = jax.nn.silu(c) @ p['w_mod'] + p['b_mod']
    mod_c = jax.nn.silu(c_ctx) @ p['w_mod'] + p['b_mod']
    sh1, sc1, g1, sh2, sc2, g2 = jnp.split(mod[:, None, :], 6, axis=-1)
    shc1, scc1, gc1, shc2, scc2, gc2 = jnp.split(mod_c, 6)
    seq = x.shape[1]
    rows = seq // GRID_W
    row = jnp.broadcast_to(jnp.arange(rows, dtype=jnp.float32)[:, None], (rows, GRID_W)).reshape(seq)
    col = jnp.broadcast_to(jnp.arange(GRID_W, dtype=jnp.float32)[None, :], (rows, GRID_W)).reshape(seq)
    lg_f = jax.nn.log_sigmoid(p['ret_logit_f'].astype(jnp.float32))
    lg_b = jax.nn.log_sigmoid(p['ret_logit_b'].astype(jnp.float32))
    k_scale = RET_QK_DIM ** -0.5

    h = modulate(rms_norm(x, p['norm1']), sh1, sc1)
    hc = modulate(rms_norm(xc, p['norm1']), shc1, scc1)
    u = h @ p['w_in']
    w_c = p['w_in'] if ctx_out else p['w_in'][:, K_OFF:G_OFF]
    off = 0 if ctx_out else K_OFF
    uc = hc @ w_c
    kc = split_heads(uc[..., K_OFF - off:V_OFF - off]) * k_scale
    vc = split_heads(uc[..., V_OFF - off:G_OFF - off])
    s_f = retention_final_state(kc, vc, lg_f, False)
    s_b = retention_final_state(kc, vc, lg_b, True)

    q = rope_2d(split_heads(u[..., Q_OFF:K_OFF]), row, col)
    k = rope_2d(split_heads(u[..., K_OFF:V_OFF]), row, col) * k_scale
    v = split_heads(u[..., V_OFF:G_OFF])
    y_hy = hyena_mixer(u[..., :HY_COLS], p)
    y_ret = retention_output(bidirectional_retention(q, k, v, lg_f, lg_b, s_f, s_b), u[..., G_OFF:])
    x = x + g1 * (jnp.concatenate([y_hy, y_ret], axis=-1) @ p['w_out'])

    if ctx_out:
        qc = split_heads(uc[..., Q_OFF:K_OFF])
        zero = jnp.zeros_like(s_f)
        yc_hy = hyena_mixer(uc[..., :HY_COLS], p)
        yc_ret = retention_output(bidirectional_retention(qc, kc, vc, lg_f, lg_b, zero, zero), uc[..., G_OFF:])
        xc = xc + gc1 * (jnp.concatenate([yc_hy, yc_ret], axis=-1) @ p['w_out'])

    x = x + g2 * conv_ffn(modulate(rms_norm(x, p['norm2']), sh2, sc2), p)
    if ctx_out:
        xc = xc + gc2 * conv_ffn(modulate(rms_norm(xc, p['norm2']), shc2, scc2), p)
    return x, xc


def setup_inputs(seed: int = 0) -> dict:
    key = jax.random.key(seed)
    ks = jax.random.split(key, 27)

    def nrm(k, shape, scale):
        return jax.random.normal(k, shape, jnp.float32) * scale

    base_logit = jnp.log(2.0 ** (5.0 + jnp.arange(RET_HEADS, dtype=jnp.float32)) - 1.0)
    return {
        'x': nrm(ks[0], (BATCH, SEQ, D_MODEL), 1.0),
        'c': nrm(ks[1], (BATCH, D_MODEL), 1.0),
        'ctx': nrm(ks[2], (BATCH, CTX_LEN, D_MODEL), 1.0),
        'c_ctx': nrm(ks[3], (D_MODEL,), 1.0),
        'w_mod': nrm(ks[4], (DEPTH, D_MODEL, 6 * D_MODEL), 0.5 * D_MODEL ** -0.5),
        'b_mod': nrm(ks[5], (DEPTH, 6 * D_MODEL), 0.02),
        'norm1': 1.0 + nrm(ks[6], (DEPTH, D_MODEL), 0.02),
        'w_in': nrm(ks[7], (DEPTH, D_MODEL, IN_COLS), D_MODEL ** -0.5),
        'hy_conv_w': nrm(ks[8], (DEPTH, 3, HY_COLS), 3 ** -0.5),
        'hy_conv_b': nrm(ks[9], (DEPTH, HY_COLS), 0.02),
        'hy_w1': nrm(ks[10], (DEPTH, HY_EMB_DIM, HY_FILTER_WIDTH), 2.0 * HY_EMB_DIM ** -0.5),
        'hy_b1': nrm(ks[11], (DEPTH, HY_FILTER_WIDTH), 0.02),
        'hy_f1': 1.0 + nrm(ks[12], (DEPTH, HY_FILTER_WIDTH), 0.02),
        'hy_w2': nrm(ks[13], (DEPTH, HY_FILTER_WIDTH, HY_FILTER_WIDTH), 2.0 * HY_FILTER_WIDTH ** -0.5),
        'hy_b2': nrm(ks[14], (DEPTH, HY_FILTER_WIDTH), 0.02),
        'hy_f2': 1.0 + nrm(ks[15], (DEPTH, HY_FILTER_WIDTH), 0.02),
        'hy_w3': nrm(ks[16], (DEPTH, HY_FILTER_WIDTH, 2 * HY_ORDER * HY_WIDTH), HY_FILTER_INIT),
        'hy_bias': nrm(ks[17], (DEPTH, HY_ORDER, HY_WIDTH), 0.5),
        'ret_logit_f': base_logit + nrm(ks[18], (DEPTH, RET_HEADS), 0.05),
        'ret_logit_b': base_logit + nrm(ks[19], (DEPTH, RET_HEADS), 0.05),
        'w_out': nrm(ks[20], (DEPTH, MIX_WIDTH, D_MODEL), MIX_WIDTH ** -0.5),
        'norm2': 1.0 + nrm(ks[21], (DEPTH, D_MODEL), 0.02),
        'ffn_w_up': nrm(ks[22], (DEPTH, D_MODEL, 2 * D_FF), D_MODEL ** -0.5),
        'ffn_conv_w': nrm(ks[23], (DEPTH, 3, 2 * D_FF), 3 ** -0.5),
        'ffn_conv_b': nrm(ks[24], (DEPTH, 2 * D_FF), 0.02),
        'ffn_w_down': nrm(ks[25], (DEPTH, D_FF, D_MODEL), D_FF ** -0.5),
        'norm_f': 1.0 + nrm(ks[26], (D_MODEL,), 0.02),
    }


def reference(x, c, ctx, c_ctx, w_mod, b_mod, norm1, w_in, hy_conv_w, hy_conv_b, hy_w1, hy_b1, hy_f1,
              hy_w2, hy_b2, hy_f2, hy_w3, hy_bias, ret_logit_f, ret_logit_b, w_out, norm2,
              ffn_w_up, ffn_conv_w, ffn_conv_b, ffn_w_down, norm_f):
    xc = ctx
    for layer in range(DEPTH):
        p = {
            'w_mod': w_mod[layer], 'b_mod': b_mod[layer], 'norm1': norm1[layer], 'w_in': w_in[layer],
            'hy_conv_w': hy_conv_w[layer], 'hy_conv_b': hy_conv_b[layer],
            'hy_w1': hy_w1[layer], 'hy_b1': hy_b1[layer], 'hy_f1': hy_f1[layer],
            'hy_w2': hy_w2[layer], 'hy_b2': hy_b2[layer], 'hy_f2': hy_f2[layer],
            'hy_w3': hy_w3[layer], 'hy_bias': hy_bias[layer],
            'ret_logit_f': ret_logit_f[layer], 'ret_logit_b': ret_logit_b[layer],
            'w_out': w_out[layer], 'norm2': norm2[layer],
            'ffn_w_up': ffn_w_up[layer], 'ffn_conv_w': ffn_conv_w[layer],
            'ffn_conv_b': ffn_conv_b[layer], 'ffn_w_down': ffn_w_down[layer],
        }
        x, xc = trunk_layer(x, xc, c, c_ctx, p, layer < DEPTH - 1)
    return rms_norm(x, norm_f)
```

```cpp
#include <hip/hip_runtime.h>
#include <hip/hip_cooperative_groups.h>
#include <cstdio>
#include <cstdint>
namespace cg = cooperative_groups;

#define LAS __attribute__((address_space(3)))
typedef unsigned short bf16;
typedef short bf16x8 __attribute__((ext_vector_type(8)));
typedef float f32x4 __attribute__((ext_vector_type(4)));
typedef float f32x2 __attribute__((ext_vector_type(2)));
typedef float f32x16 __attribute__((ext_vector_type(16)));
typedef unsigned u32x4 __attribute__((ext_vector_type(4)));
typedef unsigned u32x2 __attribute__((ext_vector_type(2)));

constexpr int DM = 1024, NB = 8, SEQ = 2048, CTXL = 256, M_TOK = NB * SEQ, M_CTX = NB * CTXL;
constexpr int HYW = 512, HYC = 1536, NIN = 3072, NREST = 1536  , DFF = 2816, NUP = 5632;
constexpr int NH = 4, DK = 64, DV = 128, CH = 128, NCHUNK = 16;
constexpr float EPS = 1e-6f;

constexpr size_t MiB = 1u << 20;
constexpr size_t WS_WINT = 0, WS_WOUTT = 6 * MiB, WS_WUPT = 8 * MiB, WS_WDNT = 19 * MiB;
constexpr size_t WS_MOD = 25 * MiB, WS_BIAS2 = 25 * MiB + 256 * 1024, WS_SUMSQ = 25 * MiB + 512 * 1024, WS_ROPE = 26 * MiB;
constexpr size_t WS_FILT = 27 * MiB, WS_HALO = 35 * MiB;
constexpr size_t WS_YCAT = 46 * MiB, WS_HC = 46 * MiB, WS_YT = 78 * MiB, WS_ZT = 94 * MiB, WS_QKVG = 142 * MiB, WS_UC = 190 * MiB, WS_KV = 193 * MiB;
constexpr size_t WS_H = 222 * MiB, WS_A2 = 222 * MiB, WS_APRE = 46 * MiB, WS_END = 256 * MiB;
constexpr int LDS_BYTES = 147456;

__device__ __forceinline__ unsigned cvt_pk_bf16(float lo, float hi) { unsigned r; asm volatile("v_cvt_pk_bf16_f32 %0, %1, %2" : "=v"(r) : "v"(lo), "v"(hi)); return r; }
__device__ __forceinline__ float bf2f(unsigned h) { return __uint_as_float(h << 16); }
__device__ __forceinline__ float bflo(unsigned w) { return __uint_as_float(w << 16); }
__device__ __forceinline__ float bfhi(unsigned w) { return __uint_as_float(w & 0xffff0000u); }
__device__ __forceinline__ unsigned short f2bf(float f) { return (unsigned short)(cvt_pk_bf16(f, 0.f) & 0xffffu); }
__device__ __forceinline__ float wave_sum(float v) {
#pragma unroll
    for (int o = 1; o < 64; o <<= 1) v += __shfl_xor(v, o);
    return v;
}
__device__ __forceinline__ float silu_f(float v) { return v / (1.0f + __expf(-v)); }
#define LDS_WAIT() asm volatile("s_waitcnt lgkmcnt(0)" ::: "memory")

namespace pg8 {
constexpr int BM = 256, BK = 64, HALF = 128, HTB = HALF * BK * 2, STAGE_BYTES = 8 * HTB, NXCD = 8, WGM = 8;
__host__ __device__ __forceinline__ int lds_byte(int r, int c) { const int st = (r >> 4) * 2 + (c >> 5), rr = r & 15, cc = c & 31, ob = rr * 64 + cc * 2; return st * 1024 + (ob ^ (((ob >> 9) & 1) << 5)); }
__host__ __device__ __forceinline__ void stage_rc(int b, int& R, int& C) { const int st = b / 1024, sb = b % 1024, swz = sb ^ (((sb >> 9) & 1) << 5); R = (st >> 1) * 16 + swz / 64; C = (st & 1) * 32 + (swz % 64) / 2; }
__host__ __device__ __forceinline__ int perm32(int rho) { const int n = rho >> 4, i = rho & 15; return 8 * (i >> 2) + 4 * n + (i & 3); }

struct Unit { int pm, pn, kind; };
struct Gemm { int K; int lda, ldb; int pairA; };

template <int NM, int NN> __device__ __forceinline__ void order_tile(int L, int& pm, int& pn) {
    constexpr int nwg = NM * NN, q = nwg / NXCD, r = nwg % NXCD;
    const int xcd = L % NXCD, off = L / NXCD;
    const int wgid = (xcd < r ? xcd * (q + 1) : r * (q + 1) + (xcd - r) * q) + off;
    constexpr int nig = WGM * NN; const int gid = wgid / nig, fm = gid * WGM, gsz = (NM - fm) < WGM ? (NM - fm) : WGM;
    pm = fm + ((wgid % nig) % gsz); pn = (wgid % nig) / gsz;
}

template <class Epi, class Sched, bool ALIGN_EPI = true, bool SP2 = true>
__device__ __forceinline__ void gemm_phase(LAS unsigned char* lds, const Gemm g, const Sched& S, const Epi& E) {
    const int tid = threadIdx.x, wid = __builtin_amdgcn_readfirstlane(tid >> 6), lane = tid & 63, wr = wid >> 2, wc = wid & 3, fr = lane & 15, fq = lane >> 4;
    const int K = g.K, nt = K / BK;
    unsigned voffA[2], voffB[2];
#pragma unroll
    for (int i = 0; i < 2; ++i) { int R, C; stage_rc(tid * 16 + i * 8192, R, C); const int Rb = Epi::PERM ? ((R & ~31) + perm32(R & 31)) : R;
        voffA[i] = (unsigned)(R * g.lda + C) * 2u; voffB[i] = (unsigned)(Rb * g.ldb + C) * 2u; }
    const size_t kstep = (size_t)(BK * 2);
    const size_t hstepA = (size_t)HALF * g.lda * 2, hstepB = (size_t)HALF * g.ldb * 2;
    const size_t pairA = (size_t)g.pairA, pairB = 2 * kstep;
    const unsigned ldsw = (unsigned)wid * 1024u;
    const int aoff = lds_byte(wr * 64 + fr, fq * 8), boff = lds_byte(wc * 32 + fr, fq * 8);
#define PG8_SA(b, h) (((b) * 2 + (h)) * HTB)
#define PG8_SB(b, h) ((4 + (b) * 2 + (h)) * HTB)
#define PG8_STAGE(bufoff, gbase, voff) do { _Pragma("unroll") for (int _i = 0; _i < 2; ++_i) \
        __builtin_amdgcn_global_load_lds((const unsigned*)((const char*)(gbase) + (voff)[_i]), (LAS unsigned*)(lds + (bufoff) + ldsw + _i * 8192), 16, 0, 0); } while (0)
#define PG8_LDA(dst, b, h) do { _Pragma("unroll") for (int m = 0; m < 4; ++m) _Pragma("unroll") for (int k = 0; k < 2; ++k) dst[m][k] = *(const LAS bf16x8*)(lds + PG8_SA(b, h) + aoff + m * 2048 + k * 1024); } while (0)
#define PG8_LDB(dst, b, h) do { _Pragma("unroll") for (int n = 0; n < 2; ++n) _Pragma("unroll") for (int k = 0; k < 2; ++k) dst[n][k] = *(const LAS bf16x8*)(lds + PG8_SB(b, h) + boff + n * 2048 + k * 1024); } while (0)
#define PG8_MMA(ai, bj, At, Bt) do { __builtin_amdgcn_s_setprio(1); _Pragma("unroll") for (int m = 0; m < 4; ++m) _Pragma("unroll") for (int n = 0; n < 2; ++n) _Pragma("unroll") for (int k = 0; k < 2; ++k) \
        acc[ai][bj][m][n] = __builtin_amdgcn_mfma_f32_16x16x32_bf16(Bt[n][k], At[m][k], acc[ai][bj][m][n], 0, 0, 0); __builtin_amdgcn_s_setprio(0); } while (0)
#define PG8_WAIT_V(n) asm volatile("s_waitcnt vmcnt(" #n ")" ::: "memory")
#define PG8_WAIT_L(n) asm volatile("s_waitcnt lgkmcnt(" #n ")" ::: "memory")
#define PG8_BAR __builtin_amdgcn_s_barrier()
#define PG8_SCHED __builtin_amdgcn_sched_barrier(0)
    Unit cur, nxt; int ui = 0;
    if (!S.next(0, cur)) return;
    f32x4 acc[2][2][4][2];
#pragma unroll
    for (int a = 0; a < 2; ++a)
#pragma unroll
        for (int b = 0; b < 2; ++b)
#pragma unroll
            for (int m = 0; m < 4; ++m)
#pragma unroll
                for (int n = 0; n < 2; ++n) acc[a][b][m][n] = (f32x4){0.f, 0.f, 0.f, 0.f};
    bf16x8 At[4][2], B0[2][2], B1[2][2];
    const char* cA; const char* cB; S.ptrs(cur, cA, cB);
    if constexpr (SP2) {
        PG8_STAGE(PG8_SB(0, 0), cB, voffB); PG8_STAGE(PG8_SB(0, 1), cB + hstepB, voffB); PG8_STAGE(PG8_SA(0, 0), cA, voffA); PG8_STAGE(PG8_SA(0, 1), cA + hstepA, voffA);
        if (wr == 1) PG8_BAR;
        PG8_WAIT_V(2); PG8_BAR;
        PG8_STAGE(PG8_SB(1, 0), cB + kstep, voffB); PG8_STAGE(PG8_SA(1, 0), cA + kstep, voffA); PG8_STAGE(PG8_SB(1, 1), cB + hstepB + kstep, voffB);
        PG8_WAIT_V(6); PG8_BAR;
    } else {
        PG8_STAGE(PG8_SB(0, 0), cB, voffB); PG8_STAGE(PG8_SA(0, 0), cA, voffA); PG8_STAGE(PG8_SB(0, 1), cB + hstepB, voffB); PG8_STAGE(PG8_SA(0, 1), cA + hstepA, voffA);
        if (wr == 1) PG8_BAR;
        PG8_WAIT_V(4); PG8_BAR;
        PG8_STAGE(PG8_SB(1, 0), cB + kstep, voffB); PG8_STAGE(PG8_SA(1, 0), cA + kstep, voffA); PG8_STAGE(PG8_SB(1, 1), cB + hstepB + kstep, voffB);
        PG8_WAIT_V(6); PG8_BAR;
    }
    for (;;) {
        const bool has_next = S.next(ui + 1, nxt);
        const char* nA = cA; const char* nB = cB; if (has_next) S.ptrs(nxt, nA, nB);
        for (int t = 0; t < nt; t += 2) {
            const bool last = (t == nt - 2);
            const char* a0 = cA + (size_t)(t >> 1) * pairA;
            const char* a1 = a0 + kstep;
            const char* a2 = last ? nA : a0 + pairA; const char* b2 = last ? nB : cB + (size_t)(t >> 1) * pairB + pairB;
            const char* a3 = a2 + kstep; const char* b3 = b2 + kstep;
            if constexpr (SP2) {
            PG8_LDB(B0, 0, 0); PG8_LDB(B1, 0, 1); PG8_SCHED; PG8_LDA(At, 0, 0); PG8_STAGE(PG8_SA(1, 1), a1 + hstepA, voffA);
            PG8_WAIT_V(8); PG8_WAIT_L(0); PG8_BAR; PG8_MMA(0, 0, At, B0); PG8_MMA(0, 1, At, B1); PG8_BAR; PG8_SCHED;
            PG8_LDA(At, 0, 1); PG8_STAGE(PG8_SB(0, 0), b2, voffB); PG8_STAGE(PG8_SB(0, 1), b2 + hstepB, voffB); PG8_STAGE(PG8_SA(0, 0), a2, voffA);
            PG8_WAIT_V(8); PG8_WAIT_L(0); PG8_BAR; PG8_MMA(1, 0, At, B0); PG8_MMA(1, 1, At, B1); PG8_BAR; PG8_SCHED;
            PG8_LDB(B0, 1, 0); PG8_LDB(B1, 1, 1); PG8_SCHED; PG8_LDA(At, 1, 0); PG8_STAGE(PG8_SA(0, 1), a2 + hstepA, voffA);
            PG8_WAIT_V(8); PG8_WAIT_L(0); PG8_BAR; PG8_MMA(0, 0, At, B0); PG8_MMA(0, 1, At, B1); PG8_BAR; PG8_SCHED;
            PG8_LDA(At, 1, 1); PG8_STAGE(PG8_SB(1, 0), b3, voffB); PG8_STAGE(PG8_SB(1, 1), b3 + hstepB, voffB); PG8_STAGE(PG8_SA(1, 0), a3, voffA);
            PG8_WAIT_V(8); PG8_WAIT_L(0); PG8_BAR; PG8_MMA(1, 0, At, B0); PG8_MMA(1, 1, At, B1); PG8_BAR; PG8_SCHED;
            } else {
            PG8_LDB(B0, 0, 0); PG8_SCHED; PG8_LDA(At, 0, 0); PG8_STAGE(PG8_SA(1, 1), a1 + hstepA, voffA);
            PG8_WAIT_L(8); PG8_BAR; PG8_WAIT_L(0); PG8_MMA(0, 0, At, B0); PG8_BAR; PG8_SCHED;
            PG8_LDB(B1, 0, 1); PG8_STAGE(PG8_SB(0, 0), b2, voffB);
            PG8_BAR; PG8_WAIT_L(0); PG8_MMA(0, 1, At, B1); PG8_BAR;
            PG8_LDA(At, 0, 1); PG8_STAGE(PG8_SA(0, 0), a2, voffA);
            PG8_BAR; PG8_WAIT_L(0); PG8_MMA(1, 0, At, B0); PG8_BAR; PG8_SCHED;
            PG8_STAGE(PG8_SB(0, 1), b2 + hstepB, voffB);
            PG8_WAIT_V(6); PG8_BAR; PG8_MMA(1, 1, At, B1); PG8_BAR;
            PG8_LDB(B0, 1, 0); PG8_SCHED; PG8_LDA(At, 1, 0); PG8_STAGE(PG8_SA(0, 1), a2 + hstepA, voffA);
            PG8_WAIT_L(8); PG8_BAR; PG8_WAIT_L(0); PG8_MMA(0, 0, At, B0); PG8_BAR; PG8_SCHED;
            PG8_LDB(B1, 1, 1); PG8_STAGE(PG8_SB(1, 0), b3, voffB);
            PG8_BAR; PG8_WAIT_L(0); PG8_MMA(0, 1, At, B1); PG8_BAR;
            PG8_LDA(At, 1, 1); PG8_STAGE(PG8_SA(1, 0), a3, voffA);
            PG8_BAR; PG8_WAIT_L(0); PG8_MMA(1, 0, At, B0); PG8_BAR; PG8_SCHED;
            PG8_STAGE(PG8_SB(1, 1), b3 + hstepB, voffB);
            PG8_WAIT_V(6); PG8_BAR; PG8_MMA(1, 1, At, B1); PG8_BAR;
            }
        }
        if constexpr (ALIGN_EPI) { if (wr == 0) PG8_BAR; }
        E(acc, cur, wr, wc, fr, fq);
        if (!has_next) break;
#pragma unroll
        for (int a = 0; a < 2; ++a)
#pragma unroll
            for (int b = 0; b < 2; ++b)
#pragma unroll
                for (int m = 0; m < 4; ++m)
#pragma unroll
                    for (int n = 0; n < 2; ++n) acc[a][b][m][n] = (f32x4){0.f, 0.f, 0.f, 0.f};
        cur = nxt; cA = nA; cB = nB; ++ui;
        if constexpr (ALIGN_EPI) { if (wr == 1) PG8_BAR; }
    }
    PG8_WAIT_V(0);
    if constexpr (!ALIGN_EPI) { if (wr == 0) PG8_BAR; }
    PG8_BAR;
#undef PG8_SA
#undef PG8_SB
#undef PG8_STAGE
#undef PG8_LDA
#undef PG8_LDB
#undef PG8_MMA
#undef PG8_WAIT_V
#undef PG8_WAIT_L
#undef PG8_BAR
#undef PG8_SCHED
}
}
struct Params {
    const float *x, *c, *ctx, *c_ctx, *w_mod, *b_mod, *norm1, *w_in, *hy_conv_w, *hy_conv_b, *hy_w1, *hy_b1, *hy_f1, *hy_w2, *hy_b2, *hy_f2, *hy_w3, *hy_bias,
        *ret_logit_f, *ret_logit_b, *w_out, *norm2, *ffn_w_up, *ffn_conv_w, *ffn_conv_b, *ffn_w_down, *norm_f;
    float* out; unsigned char* ws; int ph_lo, ph_hi;
};
#define WSP(T, off) ((T*)(p.ws + (off)))

__device__ __forceinline__ void transpose_item(const float* W, int K, int N, bf16* WT, int drow0, int k0, int n0, LAS float* scr, int lane) {
#pragma unroll 8
    for (int i = 0; i < 32; ++i) { const int kk = 2 * i + (lane >> 5); scr[kk * 33 + (lane & 31)] = W[(size_t)(k0 + kk) * N + n0 + (lane & 31)]; }
    LDS_WAIT(); asm volatile("" ::: "memory");
    const int c = lane & 7;
#pragma unroll
    for (int j = 0; j < 4; ++j) { const int n = (lane >> 3) + 8 * j; const LAS float* s = scr + (8 * c) * 33 + n;
        u32x4 o; o.x = cvt_pk_bf16(s[0 * 33], s[1 * 33]); o.y = cvt_pk_bf16(s[2 * 33], s[3 * 33]); o.z = cvt_pk_bf16(s[4 * 33], s[5 * 33]); o.w = cvt_pk_bf16(s[6 * 33], s[7 * 33]);
        *(u32x4*)(WT + (size_t)(drow0 + n) * K + k0 + 8 * c) = o; }
    LDS_WAIT(); asm volatile("" ::: "memory");
}

__device__ __forceinline__ void phase0a(const Params& p, LAS unsigned char* lds) {
    const int tid = threadIdx.x, lane = tid & 63, wave = tid >> 6, G = gridDim.x, bx = blockIdx.x;
    {
        LAS float* scr = (LAS float*)(lds + wave * 16384);
        const int gw = bx * 8 + wave, NGW = G * 8;
        constexpr int I_IN = 16 * 96, I_OUT = 16 * 32, I_UP = 16 * 176, I_DN = 44 * 32, NIT = I_IN + I_OUT + I_UP + I_DN;
        for (int it = gw; it < NIT; it += NGW) {
            int r = it;
            if (r < I_IN) { const int kb = r / 96, nb = r % 96; transpose_item(p.w_in, DM, NIN, WSP(bf16, WS_WINT), 32 * nb, 64 * kb, 32 * nb, scr, lane); continue; } r -= I_IN;
            if (r < I_OUT) { const int kb = r / 32, nb = r % 32; transpose_item(p.w_out, DM, DM, WSP(bf16, WS_WOUTT), 32 * nb, 64 * kb, 32 * nb, scr, lane); continue; } r -= I_OUT;
            if (r < I_UP) { const int kb = r / 176, nb = r % 176; const int n0 = 32 * nb;
                const int drow = (n0 < DFF) ? (256 * (n0 / 128) + (n0 % 128)) : (256 * ((n0 - DFF) / 128) + 128 + ((n0 - DFF) % 128));
                transpose_item(p.ffn_w_up, DM, NUP, WSP(bf16, WS_WUPT), drow, 64 * kb, n0, scr, lane); continue; } r -= I_UP;
            { const int kb = r / 32, nb = r % 32; transpose_item(p.ffn_w_down, DFF, DM, WSP(bf16, WS_WDNT), 32 * nb, 64 * kb, 32 * nb, scr, lane); }
        }
    }
    __syncthreads();
    if (bx < 192) {
        LAS float* sl = (LAS float*)lds;
        LAS float* red = (LAS float*)(lds + 9 * 1024 * 4);
        for (int i = tid; i < 9 * 1024; i += 512) { const int r = i >> 10, k = i & 1023; const float v = (r < 8) ? p.c[r * 1024 + k] : p.c_ctx[k]; sl[i] = silu_f(v); }
        __syncthreads();
        const int col = bx * 32 + (lane & 31), kpar = lane >> 5;
        float acc[9];
#pragma unroll
        for (int r = 0; r < 9; ++r) acc[r] = 0.f;
#pragma unroll 4
        for (int kk = 0; kk < 64; ++kk) { const int k = wave * 128 + 2 * kk + kpar; const float wv = p.w_mod[(size_t)k * 6144 + col];
#pragma unroll
            for (int r = 0; r < 9; ++r) acc[r] += sl[r * 1024 + k] * wv; }
#pragma unroll
        for (int r = 0; r < 9; ++r) { acc[r] += __shfl_xor(acc[r], 32); if (lane < 32) red[(wave * 9 + r) * 32 + lane] = acc[r]; }
        __syncthreads();
        if (tid < 9 * 32) { const int r = tid >> 5, cl = tid & 31; float s = p.b_mod[bx * 32 + cl];
#pragma unroll
            for (int w = 0; w < 8; ++w) s += red[(w * 9 + r) * 32 + cl];
            WSP(float, WS_MOD)[r * 6144 + bx * 32 + cl] = s; }
    }
    __syncthreads();
    for (int it = bx; it < 256; it += G) {
        LAS float* z = (LAS float*)lds;
        LAS float* h1 = z + 8 * 33;
        LAS float* h2 = h1 + 8 * 64;
        const int p0 = 8 * it;
        if (tid < 8 * 33) { const int pp = tid / 33, f = tid % 33; const float pos = (float)(p0 + pp); float v;
            if (f == 0) v = pos / 2047.0f;
            else { const int bi = (f - 1) & 15; const float band = 1e-4f + (float)bi * ((15.0f - 1e-4f) / 15.0f); const float ang = 6.283185307179586f * pos * band / 2048.0f; v = (f <= 16) ? cosf(ang) : -sinf(ang); }
            z[pp * 33 + f] = v; }
        __syncthreads();
        { const int pp = tid >> 6, j = tid & 63; float s = p.hy_b1[j];
#pragma unroll
          for (int f = 0; f < 33; ++f) s += z[pp * 33 + f] * p.hy_w1[f * 64 + j];
          h1[pp * 64 + j] = sinf(p.hy_f1[j] * s); }
        __syncthreads();
        { const int pp = tid >> 6, j = tid & 63; float s = p.hy_b2[j];
#pragma unroll 8
          for (int i = 0; i < 64; ++i) s += h1[pp * 64 + i] * p.hy_w2[i * 64 + j];
          h2[pp * 64 + j] = sinf(p.hy_f2[j] * s); }
        __syncthreads();
        bf16* kern = WSP(bf16, WS_FILT);
        for (int q = 0; q < 4; ++q) {
            const int col = tid + 512 * q, dir = col >> 10, o = (col >> 9) & 1, ch = col & 511;
            float a[8];
#pragma unroll
            for (int pp = 0; pp < 8; ++pp) a[pp] = 0.f;
#pragma unroll 4
            for (int j = 0; j < 64; ++j) { const float wv = p.hy_w3[j * 2048 + col];
#pragma unroll
                for (int pp = 0; pp < 8; ++pp) a[pp] += h2[pp * 64 + j] * wv; }
            const float mind = -4.605170185988091f / 1.5f, maxd = -4.605170185988091f / 0.3f;
            const float ad = fabsf(mind + (float)ch * ((maxd - mind) / 511.0f));
#pragma unroll
            for (int pp = 0; pp < 8; ++pp) a[pp] *= __expf(-((float)(p0 + pp) / 2047.0f) * ad);
            bf16* kr = kern + ((size_t)(o * 512 + ch)) * 4096;
            if (dir == 0) { u32x4 w; w.x = cvt_pk_bf16(a[0], a[1]); w.y = cvt_pk_bf16(a[2], a[3]); w.z = cvt_pk_bf16(a[4], a[5]); w.w = cvt_pk_bf16(a[6], a[7]); *(u32x4*)(kr + 2048 + p0) = w; }
            else {
#pragma unroll
                for (int pp = 0; pp < 8; ++pp) { const int pos = p0 + pp; if (pos == 0) kr[0] = 0; else kr[2048 - pos] = f2bf(a[pp]); } }
        }
        __syncthreads();
    }
    {
        const int gt = bx * 512 + tid, NT = G * 512;
        f32x2* rope = WSP(f32x2, WS_ROPE);
        for (int i = gt; i < 2048 * 32; i += NT) { const int t = i >> 5, jf = i & 31; const float pos = (jf < 16) ? (float)(t >> 6) : (float)(t & 63);
            const float inv = exp2f(-(float)(jf & 15) * (13.287712379549449f / 16.0f)); const float ang = pos * inv; rope[i] = (f32x2){cosf(ang), sinf(ang)}; }
        float* ssq = WSP(float, WS_SUMSQ);
        for (int i = gt; i < 2 * M_TOK; i += NT) ssq[i] = 0.f;
    }
}

__device__ __forceinline__ void phase0b(const Params& p) {
    const int tid = threadIdx.x, lane = tid & 63, wave = tid >> 6, G = gridDim.x;
    const int gw = blockIdx.x * 8 + wave, NGW = G * 8;
    const float* mod = WSP(float, WS_MOD);
    for (int m = gw; m < M_TOK + M_CTX; m += NGW) {
        const float* src; bf16* dst; int b;
        if (m < M_TOK) { src = p.x + (size_t)m * DM; dst = WSP(bf16, WS_H) + (size_t)m * DM; b = m >> 11; }
        else { src = p.ctx + (size_t)(m - M_TOK) * DM; dst = WSP(bf16, WS_HC) + (size_t)(m - M_TOK) * DM; b = 8; }
        f32x4 v[4]; float ss = 0.f;
#pragma unroll
        for (int j = 0; j < 4; ++j) { v[j] = ((const f32x4*)src)[lane + 64 * j]; ss += (v[j].x * v[j].x + v[j].y * v[j].y) + (v[j].z * v[j].z + v[j].w * v[j].w); }
        const float rstd = rsqrtf(wave_sum(ss) * (1.0f / DM) + EPS);
#pragma unroll
        for (int j = 0; j < 4; ++j) { const int c4 = lane + 64 * j;
            const f32x4 g = ((const f32x4*)p.norm1)[c4], sh = ((const f32x4*)(mod + b * 6144))[c4], sc = ((const f32x4*)(mod + b * 6144 + 1024))[c4];
            const f32x4 o = v[j] * rstd * g * (sc + 1.0f) + sh;
            u32x2 w; w.x = cvt_pk_bf16(o.x, o.y); w.y = cvt_pk_bf16(o.z, o.w); ((u32x2*)dst)[c4] = w; }
    }
    const bf16* wup = WSP(bf16, WS_WUPT); float* bias2 = WSP(float, WS_BIAS2);
    for (int r = gw; r < NUP; r += NGW) {
        float wv[16];
#pragma unroll
        for (int jj = 0; jj < 2; ++jj) { const u32x4 w = *(const u32x4*)(wup + (size_t)r * DM + 8 * lane + 512 * jj);
            wv[8 * jj + 0] = bflo(w.x); wv[8 * jj + 1] = bfhi(w.x); wv[8 * jj + 2] = bflo(w.y); wv[8 * jj + 3] = bfhi(w.y); wv[8 * jj + 4] = bflo(w.z); wv[8 * jj + 5] = bfhi(w.z); wv[8 * jj + 6] = bflo(w.w); wv[8 * jj + 7] = bfhi(w.w); }
        for (int b = 0; b < 8; ++b) { float s = 0.f;
#pragma unroll
            for (int jj = 0; jj < 2; ++jj) { const float* sh2 = mod + b * 6144 + 3072 + 8 * lane + 512 * jj; const f32x4 s0 = *(const f32x4*)sh2, s1 = *(const f32x4*)(sh2 + 4);
                s += wv[8 * jj + 0] * s0.x + wv[8 * jj + 1] * s0.y + wv[8 * jj + 2] * s0.z + wv[8 * jj + 3] * s0.w + wv[8 * jj + 4] * s1.x + wv[8 * jj + 5] * s1.y + wv[8 * jj + 6] * s1.z + wv[8 * jj + 7] * s1.w; }
            s = wave_sum(s); if (lane == 0) bias2[b * NUP + r] = s; }
    }
}

struct SchedP1 {
    const char* wint; const char* h; const char* hc; int G, c;
    __device__ __forceinline__ bool next(int i, pg8::Unit& u) const {
        const int L = i * G + c;
        if (L < 384) { u.kind = 0; pg8::order_tile<6, 64>(L, u.pm, u.pn); return true; }
        if (L < 768) { u.kind = 1; pg8::order_tile<64, 6>(L - 384, u.pm, u.pn); return true; }
        return false;
    }
    __device__ __forceinline__ void ptrs(const pg8::Unit& u, const char*& A, const char*& B) const {
        constexpr size_t TS = (size_t)256 * DM * 2;
        if (u.kind == 0) { A = wint + (size_t)u.pm * TS; B = h + (size_t)u.pn * TS; }
        else if (u.kind == 1) { A = h + (size_t)u.pm * TS; B = wint + (size_t)(6 + u.pn) * TS; }
        else { A = hc + (size_t)u.pm * TS; B = wint + (size_t)(7 + u.pn) * TS; }
    }
};
struct EpiP1 {
    static constexpr bool PERM = true;
    bf16* zT; bf16* qkvg; bf16* uc;
    __device__ __forceinline__ void operator()(const f32x4 (&acc)[2][2][4][2], const pg8::Unit& u, int wr, int wc, int fr, int fq) const {
        bf16* O; int ldc; if (u.kind == 0) { O = zT; ldc = M_TOK; } else if (u.kind == 1) { O = qkvg; ldc = NREST; } else { O = uc; ldc = 768; }
        const int row0 = u.pm * 256 + wr * 64 + fr, col0 = u.pn * 256 + wc * 32 + 8 * fq;
#pragma unroll
        for (int ai = 0; ai < 2; ++ai)
#pragma unroll
            for (int m = 0; m < 4; ++m) { bf16* rowp = O + (size_t)(row0 + ai * 128 + m * 16) * ldc + col0;
#pragma unroll
                for (int bj = 0; bj < 2; ++bj) { const f32x4 v0 = acc[ai][bj][m][0], v1 = acc[ai][bj][m][1];
                    u32x4 w; w.x = cvt_pk_bf16(v0[0], v0[1]); w.y = cvt_pk_bf16(v0[2], v0[3]); w.z = cvt_pk_bf16(v1[0], v1[1]); w.w = cvt_pk_bf16(v1[2], v1[3]);
                    *(u32x4*)(rowp + bj * 128) = w; } }
    }
};
template <int NM, int NN> struct SchedPlain {
    const char* A; const char* B; size_t tsA, tsB; int G, c;
    __device__ __forceinline__ bool next(int i, pg8::Unit& u) const { const int L = i * G + c; if (L >= NM * NN) return false; u.kind = 2; pg8::order_tile<NM, NN>(L, u.pm, u.pn); return true; }
    __device__ __forceinline__ void ptrs(const pg8::Unit& u, const char*& a, const char*& b) const { a = A + (size_t)u.pm * tsA; b = B + (size_t)u.pn * tsB; }
};
struct EpiP4 {
    static constexpr bool PERM = false;
    const float* x; float* out; bf16* a2; const float* mod; const float* norm2; float* ssq;
    __device__ __forceinline__ void operator()(const f32x4 (&acc)[2][2][4][2], const pg8::Unit& u, int wr, int wc, int fr, int fq) const {
        const int row0 = u.pm * 256 + wr * 64 + fr, b = u.pm >> 3, col0 = u.pn * 256 + wc * 32 + 4 * fq;
        f32x4 g1[2][2], gn[2][2];
#pragma unroll
        for (int bj = 0; bj < 2; ++bj)
#pragma unroll
            for (int n = 0; n < 2; ++n) { const int c = col0 + bj * 128 + n * 16; g1[bj][n] = *(const f32x4*)(mod + b * 6144 + 2048 + c);
                gn[bj][n] = *(const f32x4*)(norm2 + c) * (*(const f32x4*)(mod + b * 6144 + 4096 + c) + 1.0f); }
#pragma unroll
        for (int ai = 0; ai < 2; ++ai)
#pragma unroll
            for (int m = 0; m < 4; ++m) { const int r = row0 + ai * 128 + m * 16; float ss = 0.f;
#pragma unroll
                for (int bj = 0; bj < 2; ++bj)
#pragma unroll
                    for (int n = 0; n < 2; ++n) { const size_t off = (size_t)r * DM + col0 + bj * 128 + n * 16;
                        const f32x4 v = *(const f32x4*)(x + off) + g1[bj][n] * acc[ai][bj][m][n];
                        *(f32x4*)(out + off) = v; ss += (v.x * v.x + v.y * v.y) + (v.z * v.z + v.w * v.w);
                        const f32x4 a = v * gn[bj][n]; u32x2 w; w.x = cvt_pk_bf16(a.x, a.y); w.y = cvt_pk_bf16(a.z, a.w); *(u32x2*)(a2 + off) = w; }
                ss += __shfl_xor(ss, 16); ss += __shfl_xor(ss, 32);
                if (fq == 0) atomicAdd(ssq + r, ss); }
    }
};
struct EpiP5 {
    static constexpr bool PERM = true;
    bf16* apre; bf16* halo; const float* bias2; const float* ssq;
    __device__ __forceinline__ void operator()(const f32x4 (&acc)[2][2][4][2], const pg8::Unit& u, int wr, int wc, int fr, int fq) const {
        const int row0 = u.pm * 256 + wr * 64 + fr, b = u.pm >> 3, col0 = u.pn * 256 + wc * 32 + 8 * fq;
        f32x4 bv[2][2];
#pragma unroll
        for (int bj = 0; bj < 2; ++bj)
#pragma unroll
            for (int n = 0; n < 2; ++n) bv[bj][n] = *(const f32x4*)(bias2 + b * NUP + col0 + bj * 128 + 4 * n);
#pragma unroll
        for (int ai = 0; ai < 2; ++ai)
#pragma unroll
            for (int m = 0; m < 4; ++m) { const int r = row0 + ai * 128 + m * 16; const float rs = rsqrtf(ssq[r] * (1.0f / DM) + EPS);
                const int r32 = 16 * (m & 1) + fr; const bool edge = (r32 == 0) || (r32 == 31);
#pragma unroll
                for (int bj = 0; bj < 2; ++bj) { const f32x4 v0 = acc[ai][bj][m][0] * rs + bv[bj][0], v1 = acc[ai][bj][m][1] * rs + bv[bj][1];
                    u32x4 w; w.x = cvt_pk_bf16(v0[0], v0[1]); w.y = cvt_pk_bf16(v0[2], v0[3]); w.z = cvt_pk_bf16(v1[0], v1[1]); w.w = cvt_pk_bf16(v1[2], v1[3]);
                    *(u32x4*)(apre + (size_t)r * NUP + col0 + bj * 128) = w;
                    if (edge) *(u32x4*)(halo + ((size_t)(r >> 5) * 2 + (r32 == 31 ? 1 : 0)) * NUP + col0 + bj * 128) = w; } }
    }
};
struct EpiP7 {
    static constexpr bool PERM = false;
    float* out; const float* mod; float* ssq;
    __device__ __forceinline__ void operator()(const f32x4 (&acc)[2][2][4][2], const pg8::Unit& u, int wr, int wc, int fr, int fq) const {
        const int row0 = u.pm * 256 + wr * 64 + fr, b = u.pm >> 3, col0 = u.pn * 256 + wc * 32 + 4 * fq;
        f32x4 g2[2][2];
#pragma unroll
        for (int bj = 0; bj < 2; ++bj)
#pragma unroll
            for (int n = 0; n < 2; ++n) g2[bj][n] = *(const f32x4*)(mod + b * 6144 + 5120 + col0 + bj * 128 + n * 16);
#pragma unroll
        for (int ai = 0; ai < 2; ++ai)
#pragma unroll
            for (int m = 0; m < 4; ++m) { const int r = row0 + ai * 128 + m * 16; float ss = 0.f;
#pragma unroll
                for (int bj = 0; bj < 2; ++bj)
#pragma unroll
                    for (int n = 0; n < 2; ++n) { const size_t off = (size_t)r * DM + col0 + bj * 128 + n * 16;
                        const f32x4 v = *(const f32x4*)(out + off) + g2[bj][n] * acc[ai][bj][m][n];
                        *(f32x4*)(out + off) = v; ss += (v.x * v.x + v.y * v.y) + (v.z * v.z + v.w * v.w); }
                ss += __shfl_xor(ss, 16); ss += __shfl_xor(ss, 32);
                if (fq == 0) atomicAdd(ssq + r, ss); }
    }
};
__device__ __forceinline__ float log2_gamma(float logit) { return -log1pf(__expf(-logit)) * 1.4426950408889634f; }

__device__ __forceinline__ void load_qk_rope(const bf16* src, int ld, const f32x2* rope, int tpos, bool do_rope, int dg, float scale, float (&lo)[8], float (&hi)[8]) {
    const u32x4 a = *(const u32x4*)(src + 8 * dg), b = *(const u32x4*)(src + 32 + 8 * dg);
    const unsigned aw[4] = {a.x, a.y, a.z, a.w}, bw[4] = {b.x, b.y, b.z, b.w};
#pragma unroll
    for (int e = 0; e < 4; ++e) { lo[2 * e] = bflo(aw[e]); lo[2 * e + 1] = bfhi(aw[e]); hi[2 * e] = bflo(bw[e]); hi[2 * e + 1] = bfhi(bw[e]); }
    if (do_rope) {
        const f32x4* rp = (const f32x4*)(rope + (size_t)tpos * 32 + 8 * dg);
#pragma unroll
        for (int e = 0; e < 4; ++e) { const f32x4 cs = rp[e];
            float x1 = lo[2 * e], x2 = hi[2 * e]; lo[2 * e] = x1 * cs.x - x2 * cs.y; hi[2 * e] = x1 * cs.y + x2 * cs.x;
            x1 = lo[2 * e + 1]; x2 = hi[2 * e + 1]; lo[2 * e + 1] = x1 * cs.z - x2 * cs.w; hi[2 * e + 1] = x1 * cs.w + x2 * cs.z; }
    }
#pragma unroll
    for (int e = 0; e < 8; ++e) { lo[e] *= scale; hi[e] *= scale; }
}

constexpr int LDK2 = 136;
__device__ __forceinline__ void phase2(const Params& p, LAS unsigned char* lds) {
    const int tid = threadIdx.x, lane = tid & 63, wave = tid >> 6, G = gridDim.x;
    LAS bf16* kTf = (LAS bf16*)lds; LAS bf16* kTb = kTf + 64 * LDK2; LAS bf16* vT = kTb + 64 * LDK2;
    const bf16* qkvg = WSP(bf16, WS_QKVG); const bf16* uc = WSP(bf16, WS_UC); const f32x2* rope = WSP(f32x2, WS_ROPE); float* KV = WSP(float, WS_KV);
    for (int t = blockIdx.x; t < 32 * 18; t += G) {
        const int bh = t / 18, ck = t % 18, b = bh >> 2, h = bh & 3;
        const float l2f = log2_gamma(p.ret_logit_f[h]), l2b = log2_gamma(p.ret_logit_b[h]);
        const bool seq = ck < 16;
        {
            const int j = tid >> 2, dg = tid & 3; float lo[8], hi[8];
            const bf16* src = seq ? qkvg + (size_t)(b * SEQ + ck * CH + j) * NREST + 256 + h * DK : uc + (size_t)(b * CTXL + (ck - 16) * CH + j) * 768 + h * DK;
            load_qk_rope(src, 0, rope, ck * CH + j, seq, dg, 0.125f, lo, hi);
            const float wf = exp2f(l2f * (float)(127 - j)), wb = exp2f(l2b * (float)j);
#pragma unroll
            for (int e = 0; e < 8; ++e) { kTf[(8 * dg + e) * LDK2 + j] = f2bf(lo[e] * wf); kTf[(32 + 8 * dg + e) * LDK2 + j] = f2bf(hi[e] * wf);
                kTb[(8 * dg + e) * LDK2 + j] = f2bf(lo[e] * wb); kTb[(32 + 8 * dg + e) * LDK2 + j] = f2bf(hi[e] * wb); }
        }
#pragma unroll
        for (int q = 0; q < 4; ++q) {
            const int pc = tid + 512 * q, j = pc >> 4, eg = pc & 15;
            const bf16* src = seq ? qkvg + (size_t)(b * SEQ + ck * CH + j) * NREST + 512 + h * DV + 8 * eg : uc + (size_t)(b * CTXL + (ck - 16) * CH + j) * 768 + 256 + h * DV + 8 * eg;
            const u32x4 a = *(const u32x4*)src; const unsigned aw[4] = {a.x, a.y, a.z, a.w};
#pragma unroll
            for (int e = 0; e < 4; ++e) { vT[(8 * eg + 2 * e) * LDK2 + j] = (bf16)(aw[e] & 0xffffu); vT[(8 * eg + 2 * e + 1) * LDK2 + j] = (bf16)(aw[e] >> 16); }
        }
        __syncthreads();
        {
            const int dir = wave >> 2, nt0 = (wave & 3) * 2, fr = lane & 15, fq = lane >> 4;
            const LAS bf16* kT = dir ? kTb : kTf;
            f32x4 acc[4][2];
#pragma unroll
            for (int mt = 0; mt < 4; ++mt)
#pragma unroll
                for (int n = 0; n < 2; ++n) acc[mt][n] = (f32x4){0.f, 0.f, 0.f, 0.f};
#pragma unroll
            for (int ks = 0; ks < 4; ++ks) {
                bf16x8 af[4], bfr[2];
#pragma unroll
                for (int mt = 0; mt < 4; ++mt) af[mt] = *(const LAS bf16x8*)(kT + (16 * mt + fr) * LDK2 + 32 * ks + 8 * fq);
#pragma unroll
                for (int n = 0; n < 2; ++n) bfr[n] = *(const LAS bf16x8*)(vT + (16 * (nt0 + n) + fr) * LDK2 + 32 * ks + 8 * fq);
#pragma unroll
                for (int mt = 0; mt < 4; ++mt)
#pragma unroll
                    for (int n = 0; n < 2; ++n) acc[mt][n] = __builtin_amdgcn_mfma_f32_16x16x32_bf16(af[mt], bfr[n], acc[mt][n], 0, 0, 0);
            }
            float* dst = KV + ((size_t)(bh * 18 + ck) * 2 + dir) * 8192;
#pragma unroll
            for (int mt = 0; mt < 4; ++mt)
#pragma unroll
                for (int n = 0; n < 2; ++n)
#pragma unroll
                    for (int r = 0; r < 4; ++r) dst[(16 * mt + 4 * fq + r) * 128 + 16 * (nt0 + n) + fr] = acc[mt][n][r];
        }
        __syncthreads();
    }
}

constexpr int LDQ = 72, LDV = 136;
constexpr int R_Q = 0, R_K = R_Q + 128 * LDQ * 2, R_VT = R_K + 128 * LDQ * 2, R_SF = R_VT + 128 * LDV * 2, R_SB = R_SF + 128 * LDQ * 2, R_OS = R_SB + 128 * LDQ * 2, R_END = R_OS + 128 * LDV * 2;
static_assert(R_END <= LDS_BYTES, "retention LDS");
__device__ __forceinline__ void ret_task(const Params& p, LAS unsigned char* lds, int t) {
    const int tid = threadIdx.x, lane = tid & 63, wave = tid >> 6;
    LAS bf16* Qs = (LAS bf16*)(lds + R_Q); LAS bf16* Ks = (LAS bf16*)(lds + R_K); LAS bf16* vT = (LAS bf16*)(lds + R_VT);
    LAS bf16* SfT = (LAS bf16*)(lds + R_SF); LAS bf16* SbT = (LAS bf16*)(lds + R_SB); LAS bf16* Os = (LAS bf16*)(lds + R_OS);
    const bf16* qkvg = WSP(bf16, WS_QKVG); const f32x2* rope = WSP(f32x2, WS_ROPE); const float* KV = WSP(float, WS_KV); bf16* ycat = WSP(bf16, WS_YCAT);
    const int bh = t >> 4, c = t & 15, b = bh >> 2, h = bh & 3;
    const float l2f = log2_gamma(p.ret_logit_f[h]), l2b = log2_gamma(p.ret_logit_b[h]);
    const size_t tok0 = (size_t)b * SEQ + c * CH;
    {
        const int j = tid >> 2, dg = tid & 3; float lo[8], hi[8];
        const bf16* src = qkvg + (tok0 + j) * NREST + h * DK;
        load_qk_rope(src, 0, rope, c * CH + j, true, dg, 1.0f, lo, hi);
        u32x4 w; w.x = cvt_pk_bf16(lo[0], lo[1]); w.y = cvt_pk_bf16(lo[2], lo[3]); w.z = cvt_pk_bf16(lo[4], lo[5]); w.w = cvt_pk_bf16(lo[6], lo[7]); *(LAS u32x4*)(Qs + j * LDQ + 8 * dg) = w;
        w.x = cvt_pk_bf16(hi[0], hi[1]); w.y = cvt_pk_bf16(hi[2], hi[3]); w.z = cvt_pk_bf16(hi[4], hi[5]); w.w = cvt_pk_bf16(hi[6], hi[7]); *(LAS u32x4*)(Qs + j * LDQ + 32 + 8 * dg) = w;
        load_qk_rope(src + 256, 0, rope, c * CH + j, true, dg, 0.125f, lo, hi);
        w.x = cvt_pk_bf16(lo[0], lo[1]); w.y = cvt_pk_bf16(lo[2], lo[3]); w.z = cvt_pk_bf16(lo[4], lo[5]); w.w = cvt_pk_bf16(lo[6], lo[7]); *(LAS u32x4*)(Ks + j * LDQ + 8 * dg) = w;
        w.x = cvt_pk_bf16(hi[0], hi[1]); w.y = cvt_pk_bf16(hi[2], hi[3]); w.z = cvt_pk_bf16(hi[4], hi[5]); w.w = cvt_pk_bf16(hi[6], hi[7]); *(LAS u32x4*)(Ks + j * LDQ + 32 + 8 * dg) = w;
    }
#pragma unroll
    for (int q = 0; q < 4; ++q) {
        const int pc = tid + 512 * q, j = pc >> 4, eg = pc & 15;
        const u32x4 a = *(const u32x4*)(qkvg + (tok0 + j) * NREST + 512 + h * DV + 8 * eg); const unsigned aw[4] = {a.x, a.y, a.z, a.w};
#pragma unroll
        for (int e = 0; e < 4; ++e) { vT[(8 * eg + 2 * e) * LDV + j] = (bf16)(aw[e] & 0xffffu); vT[(8 * eg + 2 * e + 1) * LDV + j] = (bf16)(aw[e] >> 16); }
    }
    {
        const float* base = KV + (size_t)bh * 18 * 2 * 8192;
        const float gf128 = exp2f(l2f * 128.f), gb128 = exp2f(l2b * 128.f);
#pragma unroll
        for (int q = 0; q < 4; ++q) {
            const int gi = tid + 512 * q, d = gi >> 5, e0 = 4 * (gi & 31);
            f32x4 sf = *(const f32x4*)(base + (size_t)(16 * 2 + 0) * 8192 + gi * 4) * gf128 + *(const f32x4*)(base + (size_t)(17 * 2 + 0) * 8192 + gi * 4);
            for (int cc = 0; cc < c; ++cc) sf = sf * gf128 + *(const f32x4*)(base + (size_t)(cc * 2 + 0) * 8192 + gi * 4);
            f32x4 sb = *(const f32x4*)(base + (size_t)(16 * 2 + 1) * 8192 + gi * 4) + *(const f32x4*)(base + (size_t)(17 * 2 + 1) * 8192 + gi * 4) * gb128;
            for (int cc = 15; cc > c; --cc) sb = sb * gb128 + *(const f32x4*)(base + (size_t)(cc * 2 + 1) * 8192 + gi * 4);
#pragma unroll
            for (int e = 0; e < 4; ++e) { SfT[(e0 + e) * LDQ + d] = f2bf(sf[e]); SbT[(e0 + e) * LDQ + d] = f2bf(sb[e]); }
        }
    }
    __syncthreads();
    {
        const int fr = lane & 15, fq = lane >> 4, iloc = 16 * wave + fr;
        bf16x8 qf[2], qF[2], qB[2];
#pragma unroll
        for (int ks = 0; ks < 2; ++ks) qf[ks] = *(const LAS bf16x8*)(Qs + iloc * LDQ + 32 * ks + 8 * fq);
        {
            const float sF = exp2f(l2f * (float)(iloc + 1)), sB = exp2f(l2b * (float)(128 - iloc));
#pragma unroll
            for (int ks = 0; ks < 2; ++ks) { union { bf16x8 v; unsigned u[4]; } in, oF, oB; in.v = qf[ks];
#pragma unroll
                for (int e = 0; e < 4; ++e) { const float a = bflo(in.u[e]), bb = bfhi(in.u[e]); oF.u[e] = cvt_pk_bf16(a * sF, bb * sF); oB.u[e] = cvt_pk_bf16(a * sB, bb * sB); }
                qF[ks] = oF.v; qB[ks] = oB.v; }
        }
        f32x4 sacc[8];
#pragma unroll
        for (int jt = 0; jt < 8; ++jt) { sacc[jt] = (f32x4){0.f, 0.f, 0.f, 0.f};
#pragma unroll
            for (int ks = 0; ks < 2; ++ks) { const bf16x8 kf = *(const LAS bf16x8*)(Ks + (16 * jt + fr) * LDQ + 32 * ks + 8 * fq);
                sacc[jt] = __builtin_amdgcn_mfma_f32_16x16x32_bf16(kf, qf[ks], sacc[jt], 0, 0, 0); } }
        bf16x8 pf[4];
#pragma unroll
        for (int ks = 0; ks < 4; ++ks) { union { bf16x8 v; unsigned u[4]; } o;
#pragma unroll
            for (int half = 0; half < 2; ++half) { const int jt = 2 * ks + half; float pv[4];
#pragma unroll
                for (int r = 0; r < 4; ++r) { const int diff = iloc - (16 * jt + 4 * fq + r); const float dm = diff >= 0 ? exp2f(l2f * (float)diff) : exp2f(l2b * (float)(-diff)); pv[r] = sacc[jt][r] * dm; }
                o.u[2 * half] = cvt_pk_bf16(pv[0], pv[1]); o.u[2 * half + 1] = cvt_pk_bf16(pv[2], pv[3]); }
            pf[ks] = o.v; }
        f32x4 oacc[8];
#pragma unroll
        for (int nt = 0; nt < 8; ++nt) { oacc[nt] = (f32x4){0.f, 0.f, 0.f, 0.f};
            const LAS bf16* vrow = vT + (16 * nt + fr) * LDV;
#pragma unroll
            for (int ks = 0; ks < 4; ++ks) { union { bf16x8 v; u32x2 h[2]; } bv; bv.h[0] = *(const LAS u32x2*)(vrow + 32 * ks + 4 * fq); bv.h[1] = *(const LAS u32x2*)(vrow + 32 * ks + 16 + 4 * fq);
                oacc[nt] = __builtin_amdgcn_mfma_f32_16x16x32_bf16(pf[ks], bv.v, oacc[nt], 0, 0, 0); }
#pragma unroll
            for (int ks = 0; ks < 2; ++ks) { const bf16x8 sfv = *(const LAS bf16x8*)(SfT + (16 * nt + fr) * LDQ + 32 * ks + 8 * fq), sbv = *(const LAS bf16x8*)(SbT + (16 * nt + fr) * LDQ + 32 * ks + 8 * fq);
                oacc[nt] = __builtin_amdgcn_mfma_f32_16x16x32_bf16(qF[ks], sfv, oacc[nt], 0, 0, 0);
                oacc[nt] = __builtin_amdgcn_mfma_f32_16x16x32_bf16(qB[ks], sbv, oacc[nt], 0, 0, 0); } }
        float rs[4];
#pragma unroll
        for (int r = 0; r < 4; ++r) { float ss = 0.f;
#pragma unroll
            for (int nt = 0; nt < 8; ++nt) ss += oacc[nt][r] * oacc[nt][r];
            ss += __shfl_xor(ss, 1); ss += __shfl_xor(ss, 2); ss += __shfl_xor(ss, 4); ss += __shfl_xor(ss, 8);
            rs[r] = rsqrtf(ss * (1.0f / DV) + EPS); }
#pragma unroll
        for (int nt = 0; nt < 8; ++nt)
#pragma unroll
            for (int r = 0; r < 4; ++r) Os[(16 * wave + 4 * fq + r) * LDV + 16 * nt + fr] = f2bf(oacc[nt][r] * rs[r]);
    }
    __syncthreads();
#pragma unroll
    for (int q = 0; q < 4; ++q) {
        const int pc = tid + 512 * q, i = pc >> 4, eg = pc & 15;
        const u32x4 o = *(const LAS u32x4*)(Os + i * LDV + 8 * eg), g = *(const u32x4*)(qkvg + (tok0 + i) * NREST + 1024 + h * DV + 8 * eg);
        const unsigned ow[4] = {o.x, o.y, o.z, o.w}, gw[4] = {g.x, g.y, g.z, g.w}; unsigned rw[4];
#pragma unroll
        for (int e = 0; e < 4; ++e) rw[e] = cvt_pk_bf16(silu_f(bflo(gw[e])) * bflo(ow[e]), silu_f(bfhi(gw[e])) * bfhi(ow[e]));
        *(u32x4*)(ycat + (tok0 + i) * DM + 512 + h * DV + 8 * eg) = (u32x4){rw[0], rw[1], rw[2], rw[3]};
    }
    __syncthreads();
}

constexpr int U_ROWB = 80, U_BLKB = 8 * U_ROWB, U_PAD = 7, U_BYTES = (64 + 2 * U_PAD) * U_BLKB;
constexpr int CP_STRIDE = 8192 + 32, H_U = 0, H_CP = U_BYTES, H_KS = H_CP + 8 * CP_STRIDE, H_END = H_KS + 8192;
static_assert(H_END <= LDS_BYTES && (H_CP % 16) == 0 && (H_KS % 16) == 0, "hyena LDS");
__device__ __forceinline__ void hyena_task(const Params& p, LAS unsigned char* lds, int ch) {
    const int tid = threadIdx.x, lane = tid & 63, wave = tid >> 6;
    const bf16* zT = WSP(bf16, WS_ZT); const bf16* kern = WSP(bf16, WS_FILT); bf16* yT = WSP(bf16, WS_YT);
    for (int i = tid; i < 2 * U_PAD * U_BLKB / 16; i += 512) { const int off = (i < U_PAD * U_BLKB / 16) ? i * 16 : (64 + U_PAD) * U_BLKB + (i - U_PAD * U_BLKB / 16) * 16; *(LAS u32x4*)(lds + H_U + off) = (u32x4){0u, 0u, 0u, 0u}; }
    {
        const float w0 = p.hy_conv_w[ch], w1 = p.hy_conv_w[HYC + ch], w2 = p.hy_conv_w[2 * HYC + ch], cb = p.hy_conv_b[ch];
        const bf16* zr = zT + (size_t)ch * M_TOK;
#pragma unroll
        for (int q = 0; q < 4; ++q) { const int pc = tid + 512 * q, b = pc >> 8, t0 = 8 * (pc & 255);
            const bf16* s = zr + b * SEQ + t0; const u32x4 a = *(const u32x4*)s; const unsigned aw[4] = {a.x, a.y, a.z, a.w};
            float xv[10]; xv[0] = t0 > 0 ? bf2f(s[-1]) : 0.f; xv[9] = t0 + 8 < SEQ ? bf2f(s[8]) : 0.f;
#pragma unroll
            for (int e = 0; e < 4; ++e) { xv[1 + 2 * e] = bflo(aw[e]); xv[2 + 2 * e] = bfhi(aw[e]); }
            float o[8];
#pragma unroll
            for (int e = 0; e < 8; ++e) o[e] = w0 * xv[e] + w1 * xv[e + 1] + w2 * xv[e + 2] + cb;
            u32x4 w; w.x = cvt_pk_bf16(o[0], o[1]); w.y = cvt_pk_bf16(o[2], o[3]); w.z = cvt_pk_bf16(o[4], o[5]); w.w = cvt_pk_bf16(o[6], o[7]);
            *(LAS u32x4*)(lds + H_U + ((t0 >> 5) + U_PAD) * U_BLKB + b * U_ROWB + (t0 & 31) * 2) = w; }
    }
    const int a_ = lane & 31, hh = lane >> 5;
    unsigned ypk[2][8];
    for (int o = 0; o < 2; ++o) {
        *(LAS u32x4*)(lds + H_KS + tid * 16) = *(const u32x4*)(kern + ((size_t)(o * 512 + ch)) * 4096 + tid * 8);
        __syncthreads();
        {
            const LAS bf16* ks = (const LAS bf16*)(lds + H_KS);
#pragma unroll
            for (int s = 0; s < 8; ++s) { unsigned w[4];
#pragma unroll
                for (int e = 0; e < 4; ++e) { const int i0 = 4095 - 8 * tid - 2 * e - s, i1 = i0 - 1;
                    const unsigned lo = i0 >= 0 ? (unsigned)ks[i0 & 4095] : 0u, hi = i1 >= 0 ? (unsigned)ks[i1 & 4095] : 0u; w[e] = lo | (hi << 16); }
                *(LAS u32x4*)(lds + H_CP + s * CP_STRIDE + tid * 16) = (u32x4){w[0], w[1], w[2], w[3]}; }
        }
        __syncthreads();
        f32x16 acc[2];
#pragma unroll
        for (int i = 0; i < 16; ++i) { acc[0][i] = 0.f; acc[1][i] = 0.f; }
        {
            const int sg = 7 - (a_ & 7);
            const int abase = H_CP + sg * CP_STRIDE + (255 - (a_ >> 3) + hh) * 16;
            const int bbase = H_U + a_ * U_ROWB + 16 * hh + (8 * wave + U_PAD) * U_BLKB;
            const int dlo = 8 * wave - 63;
#pragma unroll 2
            for (int dd = 0; dd < 71; ++dd) {
                const int d = dlo + dd;
                const LAS unsigned char* ap = lds + abase - 64 * d; const LAS unsigned char* bp = lds + bbase - U_BLKB * d;
                const bf16x8 a0 = *(const LAS bf16x8*)ap, a1 = *(const LAS bf16x8*)(ap + 32);
                const bf16x8 b00 = *(const LAS bf16x8*)bp, b01 = *(const LAS bf16x8*)(bp + 32), b10 = *(const LAS bf16x8*)(bp + 4 * U_BLKB), b11 = *(const LAS bf16x8*)(bp + 4 * U_BLKB + 32);
                acc[0] = __builtin_amdgcn_mfma_f32_32x32x16_bf16(a0, b00, acc[0], 0, 0, 0);
                acc[1] = __builtin_amdgcn_mfma_f32_32x32x16_bf16(a0, b10, acc[1], 0, 0, 0);
                acc[0] = __builtin_amdgcn_mfma_f32_32x32x16_bf16(a1, b01, acc[0], 0, 0, 0);
                acc[1] = __builtin_amdgcn_mfma_f32_32x32x16_bf16(a1, b11, acc[1], 0, 0, 0);
            }
        }
        {
            const int b = lane & 7, jj = a_ >> 3, colx = 512 * (o + 1) + ch;
            const float w0 = p.hy_conv_w[colx], w1 = p.hy_conv_w[HYC + colx], w2 = p.hy_conv_w[2 * HYC + colx], cb = p.hy_conv_b[colx], sk = p.hy_bias[o * 512 + ch];
            const bf16* xr = zT + (size_t)colx * M_TOK + b * SEQ;
#pragma unroll
            for (int I2 = 0; I2 < 2; ++I2) { const int blk = 4 * (2 * wave + I2) + jj;
#pragma unroll
                for (int g4 = 0; g4 < 4; ++g4) { const int aa = 8 * g4 + 4 * hh, pos = 32 * blk + aa;
                    const u32x2 uw = *(const LAS u32x2*)(lds + H_U + (blk + U_PAD) * U_BLKB + b * U_ROWB + aa * 2);
                    const u32x2 xw = *(const u32x2*)(xr + pos);
                    float xv[6]; xv[0] = pos > 0 ? bf2f(xr[pos - 1]) : 0.f; xv[5] = pos + 4 < SEQ ? bf2f(xr[pos + 4]) : 0.f;
                    xv[1] = bflo(xw.x); xv[2] = bfhi(xw.x); xv[3] = bflo(xw.y); xv[4] = bfhi(xw.y);
                    const float uv[4] = {bflo(uw.x), bfhi(uw.x), bflo(uw.y), bfhi(uw.y)}; float y[4];
#pragma unroll
                    for (int e = 0; e < 4; ++e) { const float gate = w0 * xv[e] + w1 * xv[e + 1] + w2 * xv[e + 2] + cb; y[e] = gate * (acc[I2][4 * g4 + e] + sk * uv[e]); }
                    const unsigned p0 = cvt_pk_bf16(y[0], y[1]), p1 = cvt_pk_bf16(y[2], y[3]);
                    if (o == 0) { ypk[I2][2 * g4] = p0; ypk[I2][2 * g4 + 1] = p1; }
                    else *(u32x2*)(yT + (size_t)ch * M_TOK + b * SEQ + pos) = (u32x2){p0, p1}; } }
        }
        __syncthreads();
        if (o == 0) {
            const int b = lane & 7, jj = a_ >> 3;
#pragma unroll
            for (int I2 = 0; I2 < 2; ++I2) { const int blk = 4 * (2 * wave + I2) + jj;
#pragma unroll
                for (int g4 = 0; g4 < 4; ++g4) { const int aa = 8 * g4 + 4 * hh;
                    *(LAS u32x2*)(lds + H_U + (blk + U_PAD) * U_BLKB + b * U_ROWB + aa * 2) = (u32x2){ypk[I2][2 * g4], ypk[I2][2 * g4 + 1]}; } }
        }
    }
    __syncthreads();
}

__device__ __forceinline__ void phase3c(const Params& p, LAS unsigned char* lds) {
    const int tid = threadIdx.x, lane = tid & 63, wave = tid >> 6, G = gridDim.x;
    LAS bf16* tl = (LAS bf16*)(lds + wave * 16384);
    const bf16* yT = WSP(bf16, WS_YT); bf16* ycat = WSP(bf16, WS_YCAT);
    for (int it = blockIdx.x * 8 + wave; it < 8 * 256; it += G * 8) {
        const int cb = it >> 8, tb = it & 255;
#pragma unroll
        for (int q = 0; q < 8; ++q) { const int pc = lane + 64 * q, r = pc >> 3, c8 = pc & 7;
            *(LAS u32x4*)(tl + r * 72 + 8 * c8) = *(const u32x4*)(yT + (size_t)(64 * cb + r) * M_TOK + 64 * tb + 8 * c8); }
        LDS_WAIT(); asm volatile("" ::: "memory");
#pragma unroll
        for (int q = 0; q < 8; ++q) { const int pc = lane + 64 * q, tk = pc >> 3, c8 = pc & 7; unsigned w[4];
#pragma unroll
            for (int e = 0; e < 4; ++e) w[e] = (unsigned)tl[(8 * c8 + 2 * e) * 72 + tk] | ((unsigned)tl[(8 * c8 + 2 * e + 1) * 72 + tk] << 16);
            *(u32x4*)(ycat + (size_t)(64 * tb + tk) * DM + 64 * cb + 8 * c8) = (u32x4){w[0], w[1], w[2], w[3]}; }
        LDS_WAIT(); asm volatile("" ::: "memory");
    }
}

__device__ __forceinline__ void phase6(const Params& p) {
    const int G = gridDim.x; bf16* apre = WSP(bf16, WS_APRE); const bf16* halo = WSP(bf16, WS_HALO);
    for (int tk = blockIdx.x * 512 + threadIdx.x; tk < 512 * 352; tk += G * 512) {
        const int panel = tk / 352, cg = tk % 352, pn = cg >> 4, j0 = (cg & 15) * 8;
        const int cv = 256 * pn + j0, cgt = cv + 128;
        const int ov = 128 * pn + j0, og = DFF + ov;
        float wv[3][8], wg[3][8], bvv[8], bgg[8];
#pragma unroll
        for (int e = 0; e < 8; ++e) { bvv[e] = p.ffn_conv_b[ov + e]; bgg[e] = p.ffn_conv_b[og + e];
#pragma unroll
            for (int k = 0; k < 3; ++k) { wv[k][e] = p.ffn_conv_w[k * NUP + ov + e]; wg[k][e] = p.ffn_conv_w[k * NUP + og + e]; } }
        const int r0 = panel * 32;
        u32x4 pv, pg, cvv, cgg, nv, ng;
        const u32x4 zero = (u32x4){0u, 0u, 0u, 0u};
        if ((r0 & (SEQ - 1)) == 0) { pv = zero; pg = zero; } else { const bf16* hp = halo + ((size_t)(panel - 1) * 2 + 1) * NUP; pv = *(const u32x4*)(hp + cv); pg = *(const u32x4*)(hp + cgt); }
        cvv = *(const u32x4*)(apre + (size_t)r0 * NUP + cv); cgg = *(const u32x4*)(apre + (size_t)r0 * NUP + cgt);
        for (int rr = 0; rr < 32; ++rr) {
            const int r = r0 + rr;
            if (rr < 31) { nv = *(const u32x4*)(apre + (size_t)(r + 1) * NUP + cv); ng = *(const u32x4*)(apre + (size_t)(r + 1) * NUP + cgt); }
            else if (((r + 1) & (SEQ - 1)) == 0) { nv = zero; ng = zero; }
            else { const bf16* hp = halo + ((size_t)(panel + 1) * 2 + 0) * NUP; nv = *(const u32x4*)(hp + cv); ng = *(const u32x4*)(hp + cgt); }
            const unsigned a0[4] = {pv.x, pv.y, pv.z, pv.w}, a1[4] = {cvv.x, cvv.y, cvv.z, cvv.w}, a2[4] = {nv.x, nv.y, nv.z, nv.w};
            const unsigned g0[4] = {pg.x, pg.y, pg.z, pg.w}, g1[4] = {cgg.x, cgg.y, cgg.z, cgg.w}, g2[4] = {ng.x, ng.y, ng.z, ng.w};
            unsigned ow[4];
#pragma unroll
            for (int e = 0; e < 4; ++e) {
                const float v0 = wv[0][2 * e] * bflo(a0[e]) + wv[1][2 * e] * bflo(a1[e]) + wv[2][2 * e] * bflo(a2[e]) + bvv[2 * e];
                const float v1 = wv[0][2 * e + 1] * bfhi(a0[e]) + wv[1][2 * e + 1] * bfhi(a1[e]) + wv[2][2 * e + 1] * bfhi(a2[e]) + bvv[2 * e + 1];
                const float q0 = wg[0][2 * e] * bflo(g0[e]) + wg[1][2 * e] * bflo(g1[e]) + wg[2][2 * e] * bflo(g2[e]) + bgg[2 * e];
                const float q1 = wg[0][2 * e + 1] * bfhi(g0[e]) + wg[1][2 * e + 1] * bfhi(g1[e]) + wg[2][2 * e + 1] * bfhi(g2[e]) + bgg[2 * e + 1];
                ow[e] = cvt_pk_bf16(silu_f(q0) * v0, silu_f(q1) * v1); }
            *(u32x4*)(apre + (size_t)r * NUP + cv) = (u32x4){ow[0], ow[1], ow[2], ow[3]};
            pv = cvv; pg = cgg; cvv = nv; cgg = ng;
        }
    }
}

__device__ __forceinline__ void phase8(const Params& p) {
    const int tid = threadIdx.x, lane = tid & 63, wave = tid >> 6, G = gridDim.x;
    const float* ssq = WSP(float, WS_SUMSQ) + M_TOK;
    for (int m = blockIdx.x * 8 + wave; m < M_TOK; m += G * 8) {
        const float rs = rsqrtf(ssq[m] * (1.0f / DM) + EPS); f32x4* row = (f32x4*)(p.out + (size_t)m * DM);
#pragma unroll
        for (int j = 0; j < 4; ++j) { const int c4 = lane + 64 * j; row[c4] = row[c4] * rs * ((const f32x4*)p.norm_f)[c4]; }
    }
}
#ifndef MK_DEBUG
#define MK_DEBUG 0
#endif
#ifndef MK_MULTI
#define MK_MULTI 0
#endif
constexpr int N_PHASES = 11;
__global__ void __launch_bounds__(512, 2) fwd_kernel(Params p) {
    extern __shared__ __attribute__((aligned(16))) unsigned char lds_raw[];
    LAS unsigned char* lds = (LAS unsigned char*)lds_raw;
    cg::grid_group grid = cg::this_grid();
    const int G = gridDim.x, bx = blockIdx.x;
#define IN(k) (p.ph_lo <= (k) && (k) < p.ph_hi)
#define SEAM(k) do { if (IN(k) && IN((k) + 1)) grid.sync(); } while (0)
#if MK_DEBUG
#define DBG(call) do { call; grid.sync(); } while (0)
    if (bx == 0 && threadIdx.x < 16) WSP(unsigned, WS_DBG)[threadIdx.x] = 0u;
#else
#define DBG(call) do { } while (0)
#endif
    if (IN(0)) phase0a(p, lds);
    SEAM(0);
    DBG(chk_p0a(p));
    if (IN(1)) phase0b(p);
    SEAM(1);
    if (IN(2)) {
        pg8::Gemm g{DM, DM, DM, 256};
        SchedP1 S{(const char*)WSP(bf16, WS_WINT), (const char*)WSP(bf16, WS_H), (const char*)WSP(bf16, WS_HC), G, bx};
        EpiP1 E{WSP(bf16, WS_ZT), WSP(bf16, WS_QKVG), WSP(bf16, WS_UC)};
        pg8::gemm_phase<EpiP1, SchedP1>(lds, g, S, E);
        SchedPlain<8, 3> S2{(const char*)WSP(bf16, WS_HC), (const char*)WSP(bf16, WS_WINT) + (size_t)7 * 256 * DM * 2, (size_t)256 * DM * 2, (size_t)256 * DM * 2, G, bx};
        pg8::gemm_phase<EpiP1, SchedPlain<8, 3>>(lds, g, S2, E);
    }
    SEAM(2);
    DBG(chk_p1(p));
    if (IN(3)) phase2(p, lds);
    SEAM(3);
    if (IN(4)) {
        for (int t = bx; t < 512; t += G) ret_task(p, lds, t);
        for (int t = bx; t < 512; t += G) hyena_task(p, lds, t);
    }
    SEAM(4);
    if (IN(5)) phase3c(p, lds);
    SEAM(5);
    DBG(chk_p3(p));
    if (IN(6)) {
        pg8::Gemm g{DM, DM, DM, 256};
        SchedPlain<64, 4> S{(const char*)WSP(bf16, WS_YCAT), (const char*)WSP(bf16, WS_WOUTT), (size_t)256 * DM * 2, (size_t)256 * DM * 2, G, bx};
        EpiP4 E{p.x, p.out, WSP(bf16, WS_A2), WSP(float, WS_MOD), p.norm2, WSP(float, WS_SUMSQ)};
        pg8::gemm_phase<EpiP4, SchedPlain<64, 4>>(lds, g, S, E);
    }
    SEAM(6);
    DBG(chk_p4(p));
    if (IN(7)) {
        pg8::Gemm g{DM, DM, DM, 256};
        SchedPlain<64, 22> S{(const char*)WSP(bf16, WS_A2), (const char*)WSP(bf16, WS_WUPT), (size_t)256 * DM * 2, (size_t)256 * DM * 2, G, bx};
        EpiP5 E{WSP(bf16, WS_APRE), WSP(bf16, WS_HALO), WSP(float, WS_BIAS2), WSP(float, WS_SUMSQ)};
        pg8::gemm_phase<EpiP5, SchedPlain<64, 22>>(lds, g, S, E);
    }
    SEAM(7);
    if (IN(8)) phase6(p);
    SEAM(8);
    if (IN(9)) {
        pg8::Gemm g{DFF, NUP, DFF, 512};
        SchedPlain<64, 4> S{(const char*)WSP(bf16, WS_APRE), (const char*)WSP(bf16, WS_WDNT), (size_t)256 * NUP * 2, (size_t)256 * DFF * 2, G, bx};
        EpiP7 E{p.out, WSP(float, WS_MOD), WSP(float, WS_SUMSQ) + M_TOK};
        pg8::gemm_phase<EpiP7, SchedPlain<64, 4>>(lds, g, S, E);
    }
    SEAM(9);
    if (IN(10)) phase8(p);
#if MK_DEBUG
    grid.sync(); chk_end(p, lds); grid.sync(); dbg_emit(p);
#endif
#undef IN
#undef SEAM
}

extern "C" void kernel_launch(void* const* d_in, const int* in_sizes, int n_in, void* d_out, int out_size, void* d_ws, size_t ws_size, hipStream_t stream) {
    static int grid = 0;
    if (grid == 0) {
        if (n_in != 27 || out_size != M_TOK * DM || ws_size < WS_END) { fprintf(stderr, "kernel_launch: unexpected shapes (n_in %d out %d ws %zu)\n", n_in, out_size, ws_size); grid = -1; return; }
        int dev = 0, cus = 0, per_cu = 0;
        if (hipGetDevice(&dev) != hipSuccess || hipDeviceGetAttribute(&cus, hipDeviceAttributeMultiprocessorCount, dev) != hipSuccess) { grid = -1; return; }
        if (hipFuncSetAttribute((const void*)fwd_kernel, hipFuncAttributeMaxDynamicSharedMemorySize, LDS_BYTES) != hipSuccess) { fprintf(stderr, "kernel_launch: hipFuncSetAttribute failed\n"); grid = -1; return; }
        if (hipOccupancyMaxActiveBlocksPerMultiprocessor(&per_cu, (const void*)fwd_kernel, 512, LDS_BYTES) != hipSuccess || per_cu < 1) { fprintf(stderr, "kernel_launch: occupancy query says %d\n", per_cu); per_cu = 1; }
        (void)hipGetLastError();
        grid = cus * 1;
        fprintf(stderr, "kernel_launch: grid %d (cus %d, per_cu %d)\n", grid, cus, per_cu);
    }
    if (grid < 0) return;
    Params p{};
    const float** pp = (const float**)&p;
    for (int i = 0; i < 27; ++i) pp[i] = (const float*)d_in[i];
    p.out = (float*)d_out; p.ws = (unsigned char*)d_ws;
#if MK_MULTI
    for (int k = 0; k < N_PHASES; ++k) { p.ph_lo = k; p.ph_hi = k + 1; void* args[] = {&p};
        hipError_t e = hipLaunchCooperativeKernel((const void*)fwd_kernel, dim3(grid), dim3(512), args, LDS_BYTES, stream);
        if (e != hipSuccess) { fprintf(stderr, "kernel_launch: launch %d failed: %s\n", k, hipGetErrorString(e)); break; } }
#else
    p.ph_lo = 0; p.ph_hi = N_PHASES; void* args[] = {&p};
    hipError_t e = hipLaunchCooperativeKernel((const void*)fwd_kernel, dim3(grid), dim3(512), args, LDS_BYTES, stream);
    if (e != hipSuccess) fprintf(stderr, "kernel_launch: cooperative launch failed: %s (grid %d)\n", hipGetErrorString(e), grid);
#endif
}
```

```cpp
#include <hip/hip_runtime.h>
#include <hip/hip_cooperative_groups.h>
#include <cstdio>
#include <cstdint>
namespace cg = cooperative_groups;

#define LAS __attribute__((address_space(3)))
typedef unsigned short bf16;
typedef short bf16x8 __attribute__((ext_vector_type(8)));
typedef float f32x4 __attribute__((ext_vector_type(4)));
typedef float f32x2 __attribute__((ext_vector_type(2)));
typedef float f32x16 __attribute__((ext_vector_type(16)));
typedef unsigned u32x4 __attribute__((ext_vector_type(4)));
typedef unsigned u32x2 __attribute__((ext_vector_type(2)));

constexpr int DM = 1024, NB = 8, SEQ = 2048, CTXL = 256, M_TOK = NB * SEQ, M_CTX = NB * CTXL;
constexpr int HYW = 512, HYC = 1536, NIN = 3072, NREST = 1536  , DFF = 2816, NUP = 5632;
constexpr int NH = 4, DK = 64, DV = 128, CH = 128, NCHUNK = 16;
constexpr float EPS = 1e-6f;

constexpr size_t MiB = 1u << 20;
constexpr size_t WS_WINT = 0, WS_WOUTT = 6 * MiB, WS_WUPT = 8 * MiB, WS_WDNT = 19 * MiB;
constexpr size_t WS_MOD = 25 * MiB, WS_BIAS2 = 25 * MiB + 256 * 1024, WS_SUMSQ = 25 * MiB + 512 * 1024, WS_ROPE = 26 * MiB;
constexpr size_t WS_FILT = 27 * MiB, WS_HALO = 35 * MiB;
constexpr size_t WS_YCAT = 46 * MiB, WS_HC = 46 * MiB, WS_YT = 78 * MiB, WS_ZT = 94 * MiB, WS_QKVG = 142 * MiB, WS_UC = 190 * MiB, WS_KV = 193 * MiB;
constexpr size_t WS_SST = 229 * MiB, WS_X1B = 78 * MiB;
constexpr size_t WS_HCP = 50 * MiB;
constexpr size_t WS_BAR_BASE = 25 * MiB + 640 * 1024;
constexpr size_t WS_ROWCTR = WS_BAR_BASE + 32768, WS_CNT4 = WS_BAR_BASE + 36864, WS_CNT5 = WS_BAR_BASE + 40960;
constexpr size_t WS_ZERO_BYTES = 45056;
constexpr size_t WS_H = 222 * MiB, WS_A2 = 222 * MiB, WS_APRE = 110 * MiB, WS_END = 256 * MiB;
constexpr int LDS_BYTES = 147456;

__device__ __forceinline__ unsigned cvt_pk_bf16(float lo, float hi) { unsigned r; asm volatile("v_cvt_pk_bf16_f32 %0, %1, %2" : "=v"(r) : "v"(lo), "v"(hi)); return r; }
__device__ __forceinline__ float bf2f(unsigned h) { return __uint_as_float(h << 16); }
__device__ __forceinline__ float bflo(unsigned w) { return __uint_as_float(w << 16); }
__device__ __forceinline__ float bfhi(unsigned w) { return __uint_as_float(w & 0xffff0000u); }
__device__ __forceinline__ unsigned short f2bf(float f) { return (unsigned short)(cvt_pk_bf16(f, 0.f) & 0xffffu); }
__device__ __forceinline__ float wave_sum(float v) {
#pragma unroll
    for (int o = 1; o < 64; o <<= 1) v += __shfl_xor(v, o);
    return v;
}
__device__ __forceinline__ float silu_f(float v) { return v / (1.0f + __expf(-v)); }
#define LDS_WAIT() asm volatile("s_waitcnt lgkmcnt(0)" ::: "memory")

__device__ __forceinline__ void tile_publish(unsigned* ctr) {
    asm volatile("s_waitcnt vmcnt(0)" ::: "memory"); __syncthreads();
    if (threadIdx.x == 0) { __builtin_amdgcn_fence(__ATOMIC_RELEASE, "agent"); asm volatile("s_waitcnt vmcnt(0)" ::: "memory");
        __hip_atomic_fetch_add(ctr, 1u, __ATOMIC_RELAXED, __HIP_MEMORY_SCOPE_AGENT); }
}
__device__ __forceinline__ void tile_wait(unsigned* c0, unsigned* c1, unsigned* c2, unsigned need) {
    if (threadIdx.x == 0) { unsigned sp = 0;
        for (;;) { bool ok = __hip_atomic_load(c0, __ATOMIC_RELAXED, __HIP_MEMORY_SCOPE_AGENT) >= need;
            if (ok && c1) ok = __hip_atomic_load(c1, __ATOMIC_RELAXED, __HIP_MEMORY_SCOPE_AGENT) >= need;
            if (ok && c2) ok = __hip_atomic_load(c2, __ATOMIC_RELAXED, __HIP_MEMORY_SCOPE_AGENT) >= need;
            if (ok || ++sp > (1u << 22)) break; __builtin_amdgcn_s_sleep(4); }
        __builtin_amdgcn_fence(__ATOMIC_ACQUIRE, "agent"); asm volatile("s_waitcnt vmcnt(0)" ::: "memory"); }
    __syncthreads();
}
namespace pg8 {
constexpr int BM = 256, BK = 64, HALF = 128, HTB = HALF * BK * 2, STAGE_BYTES = 8 * HTB, NXCD = 8, WGM = 8;
__host__ __device__ __forceinline__ int lds_byte(int r, int c) { const int st = (r >> 4) * 2 + (c >> 5), rr = r & 15, cc = c & 31, ob = rr * 64 + cc * 2; return st * 1024 + (ob ^ (((ob >> 9) & 1) << 5)); }
__host__ __device__ __forceinline__ void stage_rc(int b, int& R, int& C) { const int st = b / 1024, sb = b % 1024, swz = sb ^ (((sb >> 9) & 1) << 5); R = (st >> 1) * 16 + swz / 64; C = (st & 1) * 32 + (swz % 64) / 2; }
__host__ __device__ __forceinline__ int perm32(int rho) { const int n = rho >> 4, i = rho & 15; return 8 * (i >> 2) + 4 * n + (i & 3); }

struct Unit { int pm, pn, kind; };
struct Gemm { int K; int lda, ldb; int pairA; };

template <int NM, int NN> __device__ __forceinline__ void order_tile(int L, int& pm, int& pn) {
    constexpr int nwg = NM * NN, q = nwg / NXCD, r = nwg % NXCD;
    const int xcd = L % NXCD, off = L / NXCD;
    const int wgid = (xcd < r ? xcd * (q + 1) : r * (q + 1) + (xcd - r) * q) + off;
    constexpr int nig = WGM * NN; const int gid = wgid / nig, fm = gid * WGM, gsz = (NM - fm) < WGM ? (NM - fm) : WGM;
    pm = fm + ((wgid % nig) % gsz); pn = (wgid % nig) / gsz;
}

template <class Epi, class Sched, bool ALIGN_EPI = true, bool SP2 = true>
__device__ __forceinline__ void gemm_phase(LAS unsigned char* lds, const Gemm g, const Sched& S, const Epi& E) {
    const int tid = threadIdx.x, wid = __builtin_amdgcn_readfirstlane(tid >> 6), lane = tid & 63, wr = wid >> 2, wc = wid & 3, fr = lane & 15, fq = lane >> 4;
    const int K = g.K, nt = K / BK;
    unsigned voffA[2], voffB[2];
#pragma unroll
    for (int i = 0; i < 2; ++i) { int R, C; stage_rc(tid * 16 + i * 8192, R, C); const int Rb = Epi::PERM ? ((R & ~31) + perm32(R & 31)) : R;
        voffA[i] = (unsigned)(R * g.lda + C) * 2u; voffB[i] = (unsigned)(Rb * g.ldb + C) * 2u; }
    const size_t kstep = (size_t)(BK * 2);
    const size_t hstepA = (size_t)HALF * g.lda * 2, hstepB = (size_t)HALF * g.ldb * 2;
    const size_t pairA = (size_t)g.pairA, pairB = 2 * kstep;
    const unsigned ldsw = (unsigned)wid * 1024u;
    const int aoff = lds_byte(wr * 64 + fr, fq * 8), boff = lds_byte(wc * 32 + fr, fq * 8);
#define PG8_SA(b, h) (((b) * 2 + (h)) * HTB)
#define PG8_SB(b, h) ((4 + (b) * 2 + (h)) * HTB)
#define PG8_STAGE(bufoff, gbase, voff) do { _Pragma("unroll") for (int _i = 0; _i < 2; ++_i) \
        __builtin_amdgcn_global_load_lds((const unsigned*)((const char*)(gbase) + (voff)[_i]), (LAS unsigned*)(lds + (bufoff) + ldsw + _i * 8192), 16, 0, 0); } while (0)
#define PG8_LDA(dst, b, h) do { _Pragma("unroll") for (int m = 0; m < 4; ++m) _Pragma("unroll") for (int k = 0; k < 2; ++k) dst[m][k] = *(const LAS bf16x8*)(lds + PG8_SA(b, h) + aoff + m * 2048 + k * 1024); } while (0)
#define PG8_LDB(dst, b, h) do { _Pragma("unroll") for (int n = 0; n < 2; ++n) _Pragma("unroll") for (int k = 0; k < 2; ++k) dst[n][k] = *(const LAS bf16x8*)(lds + PG8_SB(b, h) + boff + n * 2048 + k * 1024); } while (0)
#define PG8_MMA(ai, bj, At, Bt) do { __builtin_amdgcn_s_setprio(1); _Pragma("unroll") for (int m = 0; m < 4; ++m) _Pragma("unroll") for (int n = 0; n < 2; ++n) _Pragma("unroll") for (int k = 0; k < 2; ++k) \
        acc[ai][bj][m][n] = __builtin_amdgcn_mfma_f32_16x16x32_bf16(Bt[n][k], At[m][k], acc[ai][bj][m][n], 0, 0, 0); __builtin_amdgcn_s_setprio(0); } while (0)
#define PG8_WAIT_V(n) asm volatile("s_waitcnt vmcnt(" #n ")" ::: "memory")
#define PG8_WAIT_L(n) asm volatile("s_waitcnt lgkmcnt(" #n ")" ::: "memory")
#define PG8_BAR __builtin_amdgcn_s_barrier()
#define PG8_SCHED __builtin_amdgcn_sched_barrier(0)
    Unit cur, nxt; int ui = 0;
    if (!S.next(0, cur)) return;
    f32x4 acc[2][2][4][2];
#pragma unroll
    for (int a = 0; a < 2; ++a)
#pragma unroll
        for (int b = 0; b < 2; ++b)
#pragma unroll
            for (int m = 0; m < 4; ++m)
#pragma unroll
                for (int n = 0; n < 2; ++n) acc[a][b][m][n] = (f32x4){0.f, 0.f, 0.f, 0.f};
    bf16x8 At[4][2], B0[2][2], B1[2][2];
    const char* cA; const char* cB; S.ptrs(cur, cA, cB);
    if constexpr (SP2) {
        PG8_STAGE(PG8_SB(0, 0), cB, voffB); PG8_STAGE(PG8_SB(0, 1), cB + hstepB, voffB); PG8_STAGE(PG8_SA(0, 0), cA, voffA); PG8_STAGE(PG8_SA(0, 1), cA + hstepA, voffA);
        if (wr == 1) PG8_BAR;
        PG8_WAIT_V(2); PG8_BAR;
        PG8_STAGE(PG8_SB(1, 0), cB + kstep, voffB); PG8_STAGE(PG8_SA(1, 0), cA + kstep, voffA); PG8_STAGE(PG8_SB(1, 1), cB + hstepB + kstep, voffB);
        PG8_WAIT_V(6); PG8_BAR;
    } else {
        PG8_STAGE(PG8_SB(0, 0), cB, voffB); PG8_STAGE(PG8_SA(0, 0), cA, voffA); PG8_STAGE(PG8_SB(0, 1), cB + hstepB, voffB); PG8_STAGE(PG8_SA(0, 1), cA + hstepA, voffA);
        if (wr == 1) PG8_BAR;
        PG8_WAIT_V(4); PG8_BAR;
        PG8_STAGE(PG8_SB(1, 0), cB + kstep, voffB); PG8_STAGE(PG8_SA(1, 0), cA + kstep, voffA); PG8_STAGE(PG8_SB(1, 1), cB + hstepB + kstep, voffB);
        PG8_WAIT_V(6); PG8_BAR;
    }
    for (;;) {
        const bool has_next = S.next(ui + 1, nxt);
        const char* nA = cA; const char* nB = cB; if (has_next) S.ptrs(nxt, nA, nB);
        for (int t = 0; t < nt; t += 2) {
            const bool last = (t == nt - 2);
            const char* a0 = cA + (size_t)(t >> 1) * pairA;
            const char* a1 = a0 + kstep;
            const char* a2 = last ? nA : a0 + pairA; const char* b2 = last ? nB : cB + (size_t)(t >> 1) * pairB + pairB;
            const char* a3 = a2 + kstep; const char* b3 = b2 + kstep;
            if constexpr (SP2) {
            PG8_LDB(B0, 0, 0); PG8_LDB(B1, 0, 1); PG8_SCHED; PG8_LDA(At, 0, 0); PG8_STAGE(PG8_SA(1, 1), a1 + hstepA, voffA);
            PG8_WAIT_V(8); PG8_WAIT_L(0); PG8_BAR; PG8_MMA(0, 0, At, B0); PG8_MMA(0, 1, At, B1); PG8_BAR; PG8_SCHED;
            PG8_LDA(At, 0, 1); PG8_STAGE(PG8_SB(0, 0), b2, voffB); PG8_STAGE(PG8_SB(0, 1), b2 + hstepB, voffB); PG8_STAGE(PG8_SA(0, 0), a2, voffA);
            PG8_WAIT_V(8); PG8_WAIT_L(0); PG8_BAR; PG8_MMA(1, 0, At, B0); PG8_MMA(1, 1, At, B1); PG8_BAR; PG8_SCHED;
            PG8_LDB(B0, 1, 0); PG8_LDB(B1, 1, 1); PG8_SCHED; PG8_LDA(At, 1, 0); PG8_STAGE(PG8_SA(0, 1), a2 + hstepA, voffA);
            PG8_WAIT_V(8); PG8_WAIT_L(0); PG8_BAR; PG8_MMA(0, 0, At, B0); PG8_MMA(0, 1, At, B1); PG8_BAR; PG8_SCHED;
            PG8_LDA(At, 1, 1); PG8_STAGE(PG8_SB(1, 0), b3, voffB); PG8_STAGE(PG8_SB(1, 1), b3 + hstepB, voffB); PG8_STAGE(PG8_SA(1, 0), a3, voffA);
            PG8_WAIT_V(8); PG8_WAIT_L(0); PG8_BAR; PG8_MMA(1, 0, At, B0); PG8_MMA(1, 1, At, B1); PG8_BAR; PG8_SCHED;
            } else {
            PG8_LDB(B0, 0, 0); PG8_SCHED; PG8_LDA(At, 0, 0); PG8_STAGE(PG8_SA(1, 1), a1 + hstepA, voffA);
            PG8_WAIT_L(8); PG8_BAR; PG8_WAIT_L(0); PG8_MMA(0, 0, At, B0); PG8_BAR; PG8_SCHED;
            PG8_LDB(B1, 0, 1); PG8_STAGE(PG8_SB(0, 0), b2, voffB);
            PG8_BAR; PG8_WAIT_L(0); PG8_MMA(0, 1, At, B1); PG8_BAR;
            PG8_LDA(At, 0, 1); PG8_STAGE(PG8_SA(0, 0), a2, voffA);
            PG8_BAR; PG8_WAIT_L(0); PG8_MMA(1, 0, At, B0); PG8_BAR; PG8_SCHED;
            PG8_STAGE(PG8_SB(0, 1), b2 + hstepB, voffB);
            PG8_WAIT_V(6); PG8_BAR; PG8_MMA(1, 1, At, B1); PG8_BAR;
            PG8_LDB(B0, 1, 0); PG8_SCHED; PG8_LDA(At, 1, 0); PG8_STAGE(PG8_SA(0, 1), a2 + hstepA, voffA);
            PG8_WAIT_L(8); PG8_BAR; PG8_WAIT_L(0); PG8_MMA(0, 0, At, B0); PG8_BAR; PG8_SCHED;
            PG8_LDB(B1, 1, 1); PG8_STAGE(PG8_SB(1, 0), b3, voffB);
            PG8_BAR; PG8_WAIT_L(0); PG8_MMA(0, 1, At, B1); PG8_BAR;
            PG8_LDA(At, 1, 1); PG8_STAGE(PG8_SA(1, 0), a3, voffA);
            PG8_BAR; PG8_WAIT_L(0); PG8_MMA(1, 0, At, B0); PG8_BAR; PG8_SCHED;
            PG8_STAGE(PG8_SB(1, 1), b3 + hstepB, voffB);
            PG8_WAIT_V(6); PG8_BAR; PG8_MMA(1, 1, At, B1); PG8_BAR;
            }
        }
        if constexpr (ALIGN_EPI) { if (wr == 0) PG8_BAR; }
        E(acc, cur, wr, wc, fr, fq, lds);
        if (!has_next) break;
#pragma unroll
        for (int a = 0; a < 2; ++a)
#pragma unroll
            for (int b = 0; b < 2; ++b)
#pragma unroll
                for (int m = 0; m < 4; ++m)
#pragma unroll
                    for (int n = 0; n < 2; ++n) acc[a][b][m][n] = (f32x4){0.f, 0.f, 0.f, 0.f};
        cur = nxt; cA = nA; cB = nB; ++ui;
        if constexpr (ALIGN_EPI) { if (wr == 1) PG8_BAR; }
    }
    PG8_WAIT_V(0);
    if constexpr (!ALIGN_EPI) { if (wr == 0) PG8_BAR; }
    PG8_BAR;
#undef PG8_SA
#undef PG8_SB
#undef PG8_STAGE
#undef PG8_LDA
#undef PG8_LDB
#undef PG8_MMA
#undef PG8_WAIT_V
#undef PG8_WAIT_L
#undef PG8_BAR
#undef PG8_SCHED
}
}
struct Params {
    const float *x, *c, *ctx, *c_ctx, *w_mod, *b_mod, *norm1, *w_in, *hy_conv_w, *hy_conv_b, *hy_w1, *hy_b1, *hy_f1, *hy_w2, *hy_b2, *hy_f2, *hy_w3, *hy_bias,
        *ret_logit_f, *ret_logit_b, *w_out, *norm2, *ffn_w_up, *ffn_conv_w, *ffn_conv_b, *ffn_w_down, *norm_f;
    float* out; unsigned char* ws; int ph_lo, ph_hi;
};
#define WSP(T, off) ((T*)(p.ws + (off)))

__device__ __forceinline__ void transpose_item(const float* W, int K, int N, bf16* WT, int drow0, int k0, int n0, LAS float* scr, int lane) {
    float tv[32];
#pragma unroll
    for (int i = 0; i < 32; ++i) { const int kk = 2 * i + (lane >> 5); tv[i] = __builtin_nontemporal_load(W + (size_t)(k0 + kk) * N + n0 + (lane & 31)); }
#pragma unroll
    for (int i = 0; i < 32; ++i) { const int kk = 2 * i + (lane >> 5); scr[kk * 33 + (lane & 31)] = tv[i]; }
    LDS_WAIT(); asm volatile("" ::: "memory");
    const int c = lane & 7;
#pragma unroll
    for (int j = 0; j < 4; ++j) { const int n = (lane >> 3) + 8 * j; const LAS float* s = scr + (8 * c) * 33 + n;
        u32x4 o; o.x = cvt_pk_bf16(s[0 * 33], s[1 * 33]); o.y = cvt_pk_bf16(s[2 * 33], s[3 * 33]); o.z = cvt_pk_bf16(s[4 * 33], s[5 * 33]); o.w = cvt_pk_bf16(s[6 * 33], s[7 * 33]);
        *(u32x4*)(WT + (size_t)(drow0 + n) * K + k0 + 8 * c) = o; }
    LDS_WAIT(); asm volatile("" ::: "memory");
}

__device__ __forceinline__ void transposes_late(const Params& p, LAS unsigned char* lds, int slot, int nslots) {
    const int lane = threadIdx.x & 63, wave = threadIdx.x >> 6;
    LAS float* scr = (LAS float*)(lds + wave * 16384);
    constexpr int I_OUT = 16 * 32, I_UP = 16 * 176, I_DN = 44 * 32;
    for (int it = slot; it < I_OUT + I_UP + I_DN; it += nslots) {
        int r = it;
        if (r < I_OUT) { const int kb = r / 32, nb = r % 32; transpose_item(p.w_out, DM, DM, WSP(bf16, WS_WOUTT), 32 * nb, 64 * kb, 32 * nb, scr, lane); continue; } r -= I_OUT;
        if (r < I_UP) { const int kb = r / 176, nb = r % 176; const int n0 = 32 * nb;
            const int drow = (n0 < DFF) ? (256 * (n0 / 128) + (n0 % 128)) : (256 * ((n0 - DFF) / 128) + 128 + ((n0 - DFF) % 128));
            transpose_item(p.ffn_w_up, DM, NUP, WSP(bf16, WS_WUPT), drow, 64 * kb, n0, scr, lane); continue; } r -= I_UP;
        { const int kb = r / 32, nb = r % 32; transpose_item(p.ffn_w_down, DFF, DM, WSP(bf16, WS_WDNT), 32 * nb, 64 * kb, 32 * nb, scr, lane); }
    }
}
__device__ __forceinline__ void bias2_rows(const Params& p) {
    const int lane = threadIdx.x & 63, gw = blockIdx.x * 8 + (threadIdx.x >> 6), NGW = gridDim.x * 8;
    const float* mod = WSP(float, WS_MOD); const bf16* wup = WSP(bf16, WS_WUPT); float* bias2 = WSP(float, WS_BIAS2);
    for (int r = gw; r < NUP; r += NGW) {
        float wv[16];
#pragma unroll
        for (int jj = 0; jj < 2; ++jj) { const u32x4 w = *(const u32x4*)(wup + (size_t)r * DM + 8 * lane + 512 * jj);
            wv[8 * jj + 0] = bflo(w.x); wv[8 * jj + 1] = bfhi(w.x); wv[8 * jj + 2] = bflo(w.y); wv[8 * jj + 3] = bfhi(w.y); wv[8 * jj + 4] = bflo(w.z); wv[8 * jj + 5] = bfhi(w.z); wv[8 * jj + 6] = bflo(w.w); wv[8 * jj + 7] = bfhi(w.w); }
        for (int b = 0; b < 8; ++b) { float s = 0.f;
#pragma unroll
            for (int jj = 0; jj < 2; ++jj) { const float* sh2 = mod + b * 6144 + 3072 + 8 * lane + 512 * jj; const f32x4 s0 = *(const f32x4*)sh2, s1 = *(const f32x4*)(sh2 + 4);
                s += wv[8 * jj + 0] * s0.x + wv[8 * jj + 1] * s0.y + wv[8 * jj + 2] * s0.z + wv[8 * jj + 3] * s0.w + wv[8 * jj + 4] * s1.x + wv[8 * jj + 5] * s1.y + wv[8 * jj + 6] * s1.z + wv[8 * jj + 7] * s1.w; }
            s = wave_sum(s); if (lane == 0) bias2[b * NUP + r] = s; }
    }
}

__device__ __forceinline__ void phase0a(const Params& p, LAS unsigned char* lds) {
    const int tid = threadIdx.x, lane = tid & 63, wave = tid >> 6, G = gridDim.x, bx = blockIdx.x;
    if (bx >= 192) {
        LAS float* scr = (LAS float*)(lds + wave * 16384);
        for (int it = (bx - 192) * 8 + wave; it < 16 * 96; it += 512) { const int kb = it / 96, nb = it % 96;
            transpose_item(p.w_in, DM, NIN, WSP(bf16, WS_WINT), 32 * nb, 64 * kb, 32 * nb, scr, lane); }
    }
    __syncthreads();
    if (bx < 192) {
        LAS float* sl = (LAS float*)lds;
        LAS float* red = (LAS float*)(lds + 9 * 1024 * 4);
        for (int i = tid; i < 9 * 1024; i += 512) { const int r = i >> 10, k = i & 1023; const float v = (r < 8) ? p.c[r * 1024 + k] : p.c_ctx[k]; sl[i] = silu_f(v); }
        __syncthreads();
        const int col = bx * 32 + (lane & 31), kpar = lane >> 5;
        float acc[9];
#pragma unroll
        for (int r = 0; r < 9; ++r) acc[r] = 0.f;
        for (int k16 = 0; k16 < 64; k16 += 32) { float wv[32];
#pragma unroll
            for (int kk = 0; kk < 32; ++kk) wv[kk] = __builtin_nontemporal_load(p.w_mod + (size_t)(wave * 128 + 2 * (k16 + kk) + kpar) * 6144 + col);
#pragma unroll
            for (int kk = 0; kk < 32; ++kk) { const int k = wave * 128 + 2 * (k16 + kk) + kpar;
#pragma unroll
                for (int r = 0; r < 9; ++r) acc[r] += sl[r * 1024 + k] * wv[kk]; } }
#pragma unroll
        for (int r = 0; r < 9; ++r) { acc[r] += __shfl_xor(acc[r], 32); if (lane < 32) red[(wave * 9 + r) * 32 + lane] = acc[r]; }
        __syncthreads();
        if (tid < 9 * 32) { const int r = tid >> 5, cl = tid & 31; float s = p.b_mod[bx * 32 + cl];
#pragma unroll
            for (int w = 0; w < 8; ++w) s += red[(w * 9 + r) * 32 + cl];
            __hip_atomic_store(WSP(float, WS_MOD) + r * 6144 + bx * 32 + cl, s, __ATOMIC_RELAXED, __HIP_MEMORY_SCOPE_AGENT); }
        asm volatile("s_waitcnt vmcnt(0)" ::: "memory"); __syncthreads();
        if (tid == 0) __hip_atomic_fetch_add(WSP(unsigned, WS_CNT4), 1u, __ATOMIC_RELAXED, __HIP_MEMORY_SCOPE_AGENT);
    }
    __syncthreads();
    for (int it = bx; it < 256; it += G) {
        LAS float* z = (LAS float*)lds;
        LAS float* h1 = z + 8 * 33;
        LAS float* h2 = h1 + 8 * 64;
        const int p0 = 8 * it;
        if (tid < 8 * 33) { const int pp = tid / 33, f = tid % 33; const float pos = (float)(p0 + pp); float v;
            if (f == 0) v = pos / 2047.0f;
            else { const int bi = (f - 1) & 15; const float band = 1e-4f + (float)bi * ((15.0f - 1e-4f) / 15.0f); const float ang = 6.283185307179586f * pos * band / 2048.0f; v = (f <= 16) ? cosf(ang) : -sinf(ang); }
            z[pp * 33 + f] = v; }
        __syncthreads();
        { const int pp = tid >> 6, j = tid & 63; float s = p.hy_b1[j];
#pragma unroll
          for (int f = 0; f < 33; ++f) s += z[pp * 33 + f] * p.hy_w1[f * 64 + j];
          h1[pp * 64 + j] = sinf(p.hy_f1[j] * s); }
        __syncthreads();
        { const int pp = tid >> 6, j = tid & 63; float s = p.hy_b2[j];
#pragma unroll 8
          for (int i = 0; i < 64; ++i) s += h1[pp * 64 + i] * p.hy_w2[i * 64 + j];
          h2[pp * 64 + j] = sinf(p.hy_f2[j] * s); }
        __syncthreads();
        bf16* kern = WSP(bf16, WS_FILT);
        float aq[4][8];
#pragma unroll
        for (int q = 0; q < 4; ++q)
#pragma unroll
            for (int pp = 0; pp < 8; ++pp) aq[q][pp] = 0.f;
        for (int j0 = 0; j0 < 64; j0 += 16) { float wv[4][16];
#pragma unroll
            for (int q = 0; q < 4; ++q)
#pragma unroll
                for (int jj = 0; jj < 16; ++jj) wv[q][jj] = p.hy_w3[(j0 + jj) * 2048 + tid + 512 * q];
#pragma unroll
            for (int jj = 0; jj < 16; ++jj)
#pragma unroll
                for (int pp = 0; pp < 8; ++pp) { const float hv = h2[pp * 64 + j0 + jj];
#pragma unroll
                    for (int q = 0; q < 4; ++q) aq[q][pp] += hv * wv[q][jj]; } }
#pragma unroll
        for (int q = 0; q < 4; ++q) {
            const int col = tid + 512 * q, dir = col >> 10, o = (col >> 9) & 1, ch = col & 511;
            float a[8];
#pragma unroll
            for (int pp = 0; pp < 8; ++pp) a[pp] = aq[q][pp];
            const float mind = -4.605170185988091f / 1.5f, maxd = -4.605170185988091f / 0.3f;
            const float ad = fabsf(mind + (float)ch * ((maxd - mind) / 511.0f));
#pragma unroll
            for (int pp = 0; pp < 8; ++pp) a[pp] *= __expf(-((float)(p0 + pp) / 2047.0f) * ad);
            bf16* kr = kern + ((size_t)(o * 512 + ch)) * 4096;
            if (dir == 0) { u32x4 w; w.x = cvt_pk_bf16(a[0], a[1]); w.y = cvt_pk_bf16(a[2], a[3]); w.z = cvt_pk_bf16(a[4], a[5]); w.w = cvt_pk_bf16(a[6], a[7]); *(u32x4*)(kr + 2048 + p0) = w; }
            else {
#pragma unroll
                for (int pp = 0; pp < 8; ++pp) { const int pos = p0 + pp; if (pos == 0) kr[0] = 0; else kr[2048 - pos] = f2bf(a[pp]); } }
        }
        __syncthreads();
    }
    {
        const int gt = bx * 512 + tid, NT = G * 512;
        f32x2* rope = WSP(f32x2, WS_ROPE);
        for (int i = gt; i < 2048 * 32; i += NT) { const int t = i >> 5, jf = i & 31; const float pos = (jf < 16) ? (float)(t >> 6) : (float)(t & 63);
            const float inv = exp2f(-(float)(jf & 15) * (13.287712379549449f / 16.0f)); const float ang = pos * inv; rope[i] = (f32x2){cosf(ang), sinf(ang)}; }
        float* ssq = WSP(float, WS_SUMSQ);
        for (int i = gt; i < 2 * M_TOK; i += NT) ssq[i] = 0.f;
    }
}

__device__ __forceinline__ void norm_rows4(const float* src0, bf16* dst0, const float* norm1, const float* modb, int lane) {
    f32x4 v[4][4]; float ss[4];
#pragma unroll
    for (int r = 0; r < 4; ++r)
#pragma unroll
        for (int j = 0; j < 4; ++j) v[r][j] = __builtin_nontemporal_load((const f32x4*)(src0 + (size_t)r * DM) + lane + 64 * j);
#pragma unroll
    for (int r = 0; r < 4; ++r) { float s = 0.f;
#pragma unroll
        for (int j = 0; j < 4; ++j) s += (v[r][j].x * v[r][j].x + v[r][j].y * v[r][j].y) + (v[r][j].z * v[r][j].z + v[r][j].w * v[r][j].w);
        ss[r] = s; }
#pragma unroll
    for (int o = 1; o < 64; o <<= 1) {
#pragma unroll
        for (int r = 0; r < 4; ++r) ss[r] += __shfl_xor(ss[r], o); }
#pragma unroll
    for (int j = 0; j < 4; ++j) { const int c4 = lane + 64 * j;
        const f32x4 g = ((const f32x4*)norm1)[c4], sh = ((const f32x4*)modb)[c4], sc = ((const f32x4*)(modb + 1024))[c4];
        const f32x4 gg = g * (sc + 1.0f);
#pragma unroll
        for (int r = 0; r < 4; ++r) { const float rstd = rsqrtf(ss[r] * (1.0f / DM) + EPS); const f32x4 o = v[r][j] * rstd * gg + sh;
            u32x2 w; w.x = cvt_pk_bf16(o.x, o.y); w.y = cvt_pk_bf16(o.z, o.w); ((u32x2*)(dst0 + (size_t)r * DM))[c4] = w; } }
}
struct SchedOne {
    const char* A; const char* B; int pm, pn, kind;
    __device__ __forceinline__ bool next(int i, pg8::Unit& u) const { if (i != 0) return false; u.pm = pm; u.pn = pn; u.kind = kind; return true; }
    __device__ __forceinline__ void ptrs(const pg8::Unit&, const char*& a, const char*& b) const { a = A; b = B; }
};
struct EpiP1;
template <class E> __device__ __forceinline__ void phase0b(const Params& p, LAS unsigned char* lds, const E& epi) {
    const int tid = threadIdx.x, lane = tid & 63, wave = tid >> 6, G = gridDim.x, bx = blockIdx.x;
    const int gw = bx * 8 + wave, NGW = G * 8;
    const float* mod = WSP(float, WS_MOD);
    tile_wait(WSP(unsigned, WS_CNT4), nullptr, nullptr, 192u);
    for (int ch4 = gw; ch4 < (M_TOK + M_CTX) / 4; ch4 += NGW) { const int base = ch4 * 4;
        if (base < M_TOK) norm_rows4(p.x + (size_t)base * DM, WSP(bf16, WS_H) + (size_t)base * DM, p.norm1, mod + (base >> 11) * 6144, lane);
        else norm_rows4(p.ctx + (size_t)(base - M_TOK) * DM, WSP(bf16, WS_HC) + (size_t)(base - M_TOK) * DM, p.norm1, mod + 8 * 6144, lane); }
}

struct SchedP1 {
    const char* wint; const char* h; const char* hc; int G, c;
    __device__ __forceinline__ bool next(int i, pg8::Unit& u) const {
        const int L = i * G + c;
        if (L < 384) { u.kind = 0; pg8::order_tile<6, 64>(L, u.pm, u.pn); return true; }
        if (L < 768) { u.kind = 1; pg8::order_tile<64, 6>(L - 384, u.pm, u.pn); return true; }
        return false;
    }
    __device__ __forceinline__ void ptrs(const pg8::Unit& u, const char*& A, const char*& B) const {
        constexpr size_t TS = (size_t)256 * DM * 2;
        if (u.kind == 0) { A = wint + (size_t)u.pm * TS; B = h + (size_t)u.pn * TS; }
        else if (u.kind == 1) { A = h + (size_t)u.pm * TS; B = wint + (size_t)(6 + u.pn) * TS; }
        else { A = hc + (size_t)u.pm * TS; B = wint + (size_t)(7 + u.pn) * TS; }
    }
};
struct EpiP1 {
    static constexpr bool PERM = true;
    bf16* zT; bf16* qkvg; bf16* uc;
    __device__ __forceinline__ void operator()(f32x4 (&acc)[2][2][4][2], const pg8::Unit& u, int wr, int wc, int fr, int fq, LAS unsigned char* lds) const {
        bf16* O; int ldc; if (u.kind == 0) { O = zT; ldc = M_TOK; } else if (u.kind == 1) { O = qkvg; ldc = NREST; } else { O = uc; ldc = 768; }
        const int row0 = u.pm * 256 + wr * 64 + fr, col0 = u.pn * 256 + wc * 32 + 8 * fq;
#pragma unroll
        for (int ai = 0; ai < 2; ++ai)
#pragma unroll
            for (int m = 0; m < 4; ++m) { bf16* rowp = O + (size_t)(row0 + ai * 128 + m * 16) * ldc + col0;
#pragma unroll
                for (int bj = 0; bj < 2; ++bj) { const f32x4 v0 = acc[ai][bj][m][0], v1 = acc[ai][bj][m][1];
                    u32x4 w; w.x = cvt_pk_bf16(v0[0], v0[1]); w.y = cvt_pk_bf16(v0[2], v0[3]); w.z = cvt_pk_bf16(v1[0], v1[1]); w.w = cvt_pk_bf16(v1[2], v1[3]);
                    *(u32x4*)(rowp + bj * 128) = w; } }
    }
};
template <int NM, int NN> struct SchedPlain {
    const char* A; const char* B; size_t tsA, tsB; int G, c;
    __device__ __forceinline__ bool next(int i, pg8::Unit& u) const { const int L = i * G + c; if (L >= NM * NN) return false; u.kind = 2; pg8::order_tile<NM, NN>(L, u.pm, u.pn); return true; }
    __device__ __forceinline__ void ptrs(const pg8::Unit& u, const char*& a, const char*& b) const { a = A + (size_t)u.pm * tsA; b = B + (size_t)u.pn * tsB; }
};
struct EpiP4 {
    static constexpr bool PERM = false;
    const float* x; bf16* x1b; bf16* a2; const float* mod; const float* norm2; float* ssq;
    __device__ __forceinline__ void operator()(f32x4 (&acc)[2][2][4][2], const pg8::Unit& u, int wr, int wc, int fr, int fq, LAS unsigned char* lds) const {
        const int row0 = u.pm * 256 + wr * 64 + fr, b = u.pm >> 3, col0 = u.pn * 256 + wc * 32 + 4 * fq;
        f32x4 g1[2][2], gn[2][2];
#pragma unroll
        for (int bj = 0; bj < 2; ++bj)
#pragma unroll
            for (int n = 0; n < 2; ++n) { const int c = col0 + bj * 128 + n * 16; g1[bj][n] = *(const f32x4*)(mod + b * 6144 + 2048 + c);
                gn[bj][n] = *(const f32x4*)(norm2 + c) * (*(const f32x4*)(mod + b * 6144 + 4096 + c) + 1.0f); }
#pragma unroll
        for (int ai = 0; ai < 2; ++ai) {
            f32x4 xa[4][2][2];
#pragma unroll
            for (int m = 0; m < 4; ++m)
#pragma unroll
                for (int bj = 0; bj < 2; ++bj)
#pragma unroll
                    for (int n = 0; n < 2; ++n) xa[m][bj][n] = *(const f32x4*)(x + (size_t)(row0 + ai * 128 + m * 16) * DM + col0 + bj * 128 + n * 16);
            asm volatile("" ::: "memory");
#pragma unroll
            for (int m = 0; m < 4; ++m) { const int r = row0 + ai * 128 + m * 16; float ss = 0.f;
#pragma unroll
                for (int bj = 0; bj < 2; ++bj)
#pragma unroll
                    for (int n = 0; n < 2; ++n) { const size_t off = (size_t)r * DM + col0 + bj * 128 + n * 16;
                        const f32x4 v = xa[m][bj][n] + g1[bj][n] * acc[ai][bj][m][n];
                        { u32x2 wx; wx.x = cvt_pk_bf16(v.x, v.y); wx.y = cvt_pk_bf16(v.z, v.w); *(u32x2*)(x1b + off) = wx; }
                        ss += (v.x * v.x + v.y * v.y) + (v.z * v.z + v.w * v.w);
                        const f32x4 a = v * gn[bj][n]; u32x2 w; w.x = cvt_pk_bf16(a.x, a.y); w.y = cvt_pk_bf16(a.z, a.w); *(u32x2*)(a2 + off) = w; }
                ss += __shfl_xor(ss, 16); ss += __shfl_xor(ss, 32);
                if (fq == 0) atomicAdd(ssq + r, ss); }
        }
    }
};
#ifndef MK_DPP
#define MK_DPP 1
#endif
__device__ __forceinline__ float rot_prev(float v, int lane) {
#if MK_DPP
    return __int_as_float(__builtin_amdgcn_update_dpp(0, __float_as_int(v), 0x121, 0xF, 0xF, false));
#else
    return __shfl(v, (lane & 48) | ((lane + 15) & 15));
#endif
}
__device__ __forceinline__ float rot_next(float v, int lane) {
#if MK_DPP
    return __int_as_float(__builtin_amdgcn_update_dpp(0, __float_as_int(v), 0x12F, 0xF, 0xF, false));
#else
    return __shfl(v, (lane & 48) | ((lane + 1) & 15));
#endif
}
constexpr int LDS_X = 131072;
struct EpiP5 {
    static constexpr bool PERM = true;
    bf16* act; bf16* halo4; const float* bias2; const float* ssq; const float* cw; const float* cb;
    __device__ __forceinline__ void operator()(f32x4 (&acc)[2][2][4][2], const pg8::Unit& u, int wr, int wc, int fr, int fq, LAS unsigned char* lds) const {
        const int lane = threadIdx.x & 63;
        const int row0 = u.pm * 256 + wr * 64 + fr, b = u.pm >> 3, cp0 = u.pn * 256 + wc * 32 + 8 * fq;
        LAS f32x4* X = (LAS f32x4*)(lds + LDS_X);
#define XIDX(ai_, wr_, wh_, bj_, n_) ((((((ai_) * 2 + (wr_)) * 2 + (wh_)) * 2 + (bj_)) * 4 + wc) * 8 + fq * 2 + (n_))
        {
            f32x4 bv[2][2];
#pragma unroll
            for (int bj = 0; bj < 2; ++bj)
#pragma unroll
                for (int n = 0; n < 2; ++n) bv[bj][n] = *(const f32x4*)(bias2 + b * NUP + cp0 + bj * 128 + 4 * n);
#pragma unroll
            for (int ai = 0; ai < 2; ++ai)
#pragma unroll
                for (int m = 0; m < 4; ++m) { const float rs = rsqrtf(ssq[row0 + ai * 128 + m * 16] * (1.0f / DM) + EPS);
#pragma unroll
                    for (int bj = 0; bj < 2; ++bj)
#pragma unroll
                        for (int n = 0; n < 2; ++n) acc[ai][bj][m][n] = acc[ai][bj][m][n] * rs + bv[bj][n]; }
        }
#pragma unroll
        for (int ai = 0; ai < 2; ++ai) {
            if (fr == 0) {
#pragma unroll
                for (int bj = 0; bj < 2; ++bj)
#pragma unroll
                    for (int n = 0; n < 2; ++n) X[XIDX(ai, wr, 0, bj, n)] = acc[ai][bj][0][n]; }
            if (fr == 15) {
#pragma unroll
                for (int bj = 0; bj < 2; ++bj)
#pragma unroll
                    for (int n = 0; n < 2; ++n) X[XIDX(ai, wr, 1, bj, n)] = acc[ai][bj][3][n]; }
        }
        if (wr == 0 && fr < 2) {
#pragma unroll
            for (int bj = 0; bj < 2; ++bj) { const f32x4 v0 = acc[0][bj][0][0], v1 = acc[0][bj][0][1];
                u32x4 w; w.x = cvt_pk_bf16(v0[0], v0[1]); w.y = cvt_pk_bf16(v0[2], v0[3]); w.z = cvt_pk_bf16(v1[0], v1[1]); w.w = cvt_pk_bf16(v1[2], v1[3]);
                *(u32x4*)(halo4 + ((size_t)u.pm * 4 + fr) * NUP + cp0 + bj * 128) = w; } }
        if (wr == 1 && fr >= 14) {
#pragma unroll
            for (int bj = 0; bj < 2; ++bj) { const f32x4 v0 = acc[1][bj][3][0], v1 = acc[1][bj][3][1];
                u32x4 w; w.x = cvt_pk_bf16(v0[0], v0[1]); w.y = cvt_pk_bf16(v0[2], v0[3]); w.z = cvt_pk_bf16(v1[0], v1[1]); w.w = cvt_pk_bf16(v1[2], v1[3]);
                *(u32x4*)(halo4 + ((size_t)u.pm * 4 + 2 + (fr - 14)) * NUP + cp0 + bj * 128) = w; } }
        LAS f32x4* WL = (LAS f32x4*)(lds + LDS_X + 8192);
        { const int t = threadIdx.x; if (t < 256) { const int k = t >> 6, bj = (t >> 5) & 1, c4 = t & 31;
            WL[(k * 2 + bj) * 32 + c4] = *(const f32x4*)((k < 3 ? cw + k * NUP : cb) + bj * DFF + u.pn * 128 + 4 * c4); } }
        asm volatile("s_waitcnt vmcnt(0) lgkmcnt(0)" ::: "memory"); __builtin_amdgcn_s_barrier(); asm volatile("" ::: "memory");
        const bool f0 = (fr == 0), f15 = (fr == 15);
        const f32x4 zero4 = (f32x4){0.f, 0.f, 0.f, 0.f};
#pragma unroll
        for (int n = 0; n < 2; ++n) {
            const int ov = u.pn * 128 + wc * 32 + 8 * fq + 4 * n, wo = (wc * 32 + 8 * fq + 4 * n) >> 2;
#pragma unroll
            for (int ai = 0; ai < 2; ++ai) {
#pragma unroll
                for (int m = 0; m < 4; ++m) {
                    f32x4 res[2];
#pragma unroll
                    for (int bj = 0; bj < 2; ++bj) {
                        const f32x4 w0 = WL[(0 * 2 + bj) * 32 + wo], w1 = WL[(1 * 2 + bj) * 32 + wo], w2 = WL[(2 * 2 + bj) * 32 + wo], bb = WL[(3 * 2 + bj) * 32 + wo];
                        const f32x4 c_ = acc[ai][bj][m][n];
                        const f32x4 up = (m > 0) ? acc[ai][bj][m - 1][n] : c_;
                        const f32x4 dn = (m < 3) ? acc[ai][bj][m + 1][n] : c_;
                        f32x4 pv, nv;
#pragma unroll
                        for (int e = 0; e < 4; ++e) { pv[e] = rot_prev(f15 ? up[e] : c_[e], lane); nv[e] = rot_next(f0 ? dn[e] : c_[e], lane); }
                        if (m == 0) { f32x4 ep;
                            if (wr == 1) ep = X[XIDX(ai, 0, 1, bj, n)]; else if (ai == 1) ep = X[XIDX(0, 1, 1, bj, n)]; else ep = zero4;
                            pv = f0 ? ep : pv; }
                        if (m == 3) { f32x4 en;
                            if (wr == 0) en = X[XIDX(ai, 1, 0, bj, n)]; else if (ai == 0) en = X[XIDX(1, 0, 0, bj, n)]; else en = zero4;
                            nv = f15 ? en : nv; }
                        res[bj] = w0 * pv + w1 * c_ + w2 * nv + bb;
                    }
                    u32x2 o2; o2.x = cvt_pk_bf16(silu_f(res[1][0]) * res[0][0], silu_f(res[1][1]) * res[0][1]); o2.y = cvt_pk_bf16(silu_f(res[1][2]) * res[0][2], silu_f(res[1][3]) * res[0][3]);
                    *(u32x2*)(act + (size_t)(row0 + ai * 128 + m * 16) * DFF + ov) = o2;
                }
                asm volatile("" ::: "memory");
            }
        }
#undef XIDX
    }
};
constexpr size_t WS_XCH = 26 * MiB + 512 * 1024;
constexpr size_t WS_CNT = WS_BAR_BASE + 16384;
struct EpiP7 {
    static constexpr bool PERM = false;
    float* out; const bf16* x1b; const float* mod; const float* norm_f; float* xch; unsigned* cnt;
    __device__ __forceinline__ void operator()(f32x4 (&acc)[2][2][4][2], const pg8::Unit& u, int wr, int wc, int fr, int fq, LAS unsigned char* lds) const {
        const int tid = threadIdx.x;
        const int row0 = u.pm * 256 + wr * 64 + fr, b = u.pm >> 3, col0 = u.pn * 256 + wc * 32 + 4 * fq;
        LAS float* red = (LAS float*)(lds + LDS_X);
        LAS float* rsl = red + 1024;
        f32x4 g2[2][2];
#pragma unroll
        for (int bj = 0; bj < 2; ++bj)
#pragma unroll
            for (int n = 0; n < 2; ++n) g2[bj][n] = *(const f32x4*)(mod + b * 6144 + 5120 + col0 + bj * 128 + n * 16);
        u32x2 xb[2][4][2][2];
#pragma unroll
        for (int ai = 0; ai < 2; ++ai)
#pragma unroll
            for (int m = 0; m < 4; ++m)
#pragma unroll
                for (int bj = 0; bj < 2; ++bj)
#pragma unroll
                    for (int n = 0; n < 2; ++n) xb[ai][m][bj][n] = *(const u32x2*)(x1b + (size_t)(u.pm * 256 + ai * 128 + wr * 64 + m * 16 + fr) * DM + col0 + bj * 128 + n * 16);
        asm volatile("" ::: "memory");
#pragma unroll
        for (int ai = 0; ai < 2; ++ai)
#pragma unroll
            for (int m = 0; m < 4; ++m) { const int rl = ai * 128 + wr * 64 + m * 16 + fr; float ss = 0.f;
#pragma unroll
                for (int bj = 0; bj < 2; ++bj)
#pragma unroll
                    for (int n = 0; n < 2; ++n) {
                        const u32x2 xw = xb[ai][m][bj][n];
                        const f32x4 v = (f32x4){bflo(xw.x), bfhi(xw.x), bflo(xw.y), bfhi(xw.y)} + g2[bj][n] * acc[ai][bj][m][n];
                        acc[ai][bj][m][n] = v; ss += (v.x * v.x + v.y * v.y) + (v.z * v.z + v.w * v.w); }
                ss += __shfl_xor(ss, 16); ss += __shfl_xor(ss, 32);
                if (fq == 0) red[rl * 4 + wc] = ss; }
        asm volatile("s_waitcnt lgkmcnt(0)" ::: "memory"); __builtin_amdgcn_s_barrier(); asm volatile("" ::: "memory");
        if (tid < 256) { const f32x4 r4 = *(const LAS f32x4*)(red + tid * 4);
            __hip_atomic_store(xch + (size_t)(u.pm * 256 + tid) * 4 + u.pn, (r4.x + r4.y) + (r4.z + r4.w), __ATOMIC_RELAXED, __HIP_MEMORY_SCOPE_AGENT); }
        asm volatile("s_waitcnt vmcnt(0)" ::: "memory"); __builtin_amdgcn_s_barrier(); asm volatile("" ::: "memory");
        if (tid == 0) { __hip_atomic_fetch_add(cnt + 64 * u.pm, 1u, __ATOMIC_RELAXED, __HIP_MEMORY_SCOPE_AGENT);
            unsigned sp = 0; while (__hip_atomic_load(cnt + 64 * u.pm, __ATOMIC_RELAXED, __HIP_MEMORY_SCOPE_AGENT) < 4u) { __builtin_amdgcn_s_sleep(2); if (++sp > (1u << 22)) break; } }
        asm volatile("s_waitcnt vmcnt(0) lgkmcnt(0)" ::: "memory"); __builtin_amdgcn_s_barrier(); asm volatile("" ::: "memory");
        if (tid < 256) { const float* s = xch + (size_t)(u.pm * 256 + tid) * 4; float t = 0.f;
#pragma unroll
            for (int k = 0; k < 4; ++k) t += __hip_atomic_load(s + k, __ATOMIC_RELAXED, __HIP_MEMORY_SCOPE_AGENT);
            rsl[tid] = rsqrtf(t * (1.0f / DM) + EPS); }
        asm volatile("s_waitcnt vmcnt(0) lgkmcnt(0)" ::: "memory"); __builtin_amdgcn_s_barrier(); asm volatile("" ::: "memory");
        f32x4 nf[2][2];
#pragma unroll
        for (int bj = 0; bj < 2; ++bj)
#pragma unroll
            for (int n = 0; n < 2; ++n) nf[bj][n] = *(const f32x4*)(norm_f + col0 + bj * 128 + n * 16);
#pragma unroll
        for (int ai = 0; ai < 2; ++ai)
#pragma unroll
            for (int m = 0; m < 4; ++m) { const int rl = ai * 128 + wr * 64 + m * 16 + fr; const float rs = rsl[rl];
#pragma unroll
                for (int bj = 0; bj < 2; ++bj)
#pragma unroll
                    for (int n = 0; n < 2; ++n) *(f32x4*)(out + (size_t)(u.pm * 256 + rl) * DM + col0 + bj * 128 + n * 16) = acc[ai][bj][m][n] * rs * nf[bj][n]; }
    }
};
__device__ __forceinline__ float log2_gamma(float logit) { return -log1pf(__expf(-logit)) * 1.4426950408889634f; }

__device__ __forceinline__ void load_qk_rope(const bf16* src, int ld, const f32x2* rope, int tpos, bool do_rope, int dg, float scale, float (&lo)[8], float (&hi)[8]) {
    const u32x4 a = *(const u32x4*)(src + 8 * dg), b = *(const u32x4*)(src + 32 + 8 * dg);
    const unsigned aw[4] = {a.x, a.y, a.z, a.w}, bw[4] = {b.x, b.y, b.z, b.w};
#pragma unroll
    for (int e = 0; e < 4; ++e) { lo[2 * e] = bflo(aw[e]); lo[2 * e + 1] = bfhi(aw[e]); hi[2 * e] = bflo(bw[e]); hi[2 * e + 1] = bfhi(bw[e]); }
    if (do_rope) {
        const f32x4* rp = (const f32x4*)(rope + (size_t)tpos * 32 + 8 * dg);
#pragma unroll
        for (int e = 0; e < 4; ++e) { const f32x4 cs = rp[e];
            float x1 = lo[2 * e], x2 = hi[2 * e]; lo[2 * e] = x1 * cs.x - x2 * cs.y; hi[2 * e] = x1 * cs.y + x2 * cs.x;
            x1 = lo[2 * e + 1]; x2 = hi[2 * e + 1]; lo[2 * e + 1] = x1 * cs.z - x2 * cs.w; hi[2 * e + 1] = x1 * cs.w + x2 * cs.z; }
    }
#pragma unroll
    for (int e = 0; e < 8; ++e) { lo[e] *= scale; hi[e] *= scale; }
}

constexpr int LDK2 = 136;
typedef short s16x4 __attribute__((ext_vector_type(4)));
struct KvRaw { u32x4 ka, kb, v[4]; f32x4 rp[4]; };
__device__ __forceinline__ void kv_issue(const Params& p, int t, int tid, KvRaw& r) {
    const bf16* qkvg = WSP(bf16, WS_QKVG); const bf16* uc = WSP(bf16, WS_UC); const f32x2* rope = WSP(f32x2, WS_ROPE);
    const int bh = t < 512 ? (t >> 4) : ((t - 512) >> 1), ck = t < 512 ? (t & 15) : 16 + ((t - 512) & 1), b = bh >> 2, h = bh & 3; const bool seq = ck < 16;
    const int j = tid >> 2, dg = tid & 3;
    const bf16* ks = seq ? qkvg + (size_t)(b * SEQ + ck * CH + j) * NREST + 256 + h * DK : uc + (size_t)(b * CTXL + (ck - 16) * CH + j) * 768 + h * DK;
    r.ka = *(const u32x4*)(ks + 8 * dg); r.kb = *(const u32x4*)(ks + 32 + 8 * dg);
    const f32x4* rp = (const f32x4*)(rope + (size_t)((ck * CH + j) & (SEQ - 1)) * 32 + 8 * dg);
#pragma unroll
    for (int e = 0; e < 4; ++e) r.rp[e] = rp[e];
#pragma unroll
    for (int q = 0; q < 4; ++q) { const int pc = tid + 512 * q, jv = pc >> 4, eg = pc & 15;
        r.v[q] = *(const u32x4*)(seq ? qkvg + (size_t)(b * SEQ + ck * CH + jv) * NREST + 512 + h * DV + 8 * eg : uc + (size_t)(b * CTXL + (ck - 16) * CH + jv) * 768 + 256 + h * DV + 8 * eg); }
}
__device__ __forceinline__ void phase2(const Params& p, LAS unsigned char* lds) {
    const int tid = threadIdx.x, lane = tid & 63, wave = tid >> 6, G = gridDim.x;
    constexpr int LDKR = 72, LDVR = 136;
    LAS bf16* Kf = (LAS bf16*)lds; LAS bf16* Kb = Kf + 128 * LDKR; LAS bf16* Vr = Kb + 128 * LDKR;
    float* KV = WSP(float, WS_KV);
    constexpr int NT = 32 * 18;
    KvRaw cur; kv_issue(p, blockIdx.x, tid, cur);
    for (int t = blockIdx.x; t < NT; t += G) {
        const int bh = t < 512 ? (t >> 4) : ((t - 512) >> 1), ck = t < 512 ? (t & 15) : 16 + ((t - 512) & 1), h = bh & 3;
        if (t >= 512) {
            if (tid == 0) { unsigned* ctr = WSP(unsigned, WS_ROWCTR); unsigned sp = 0;
                while (__hip_atomic_load(ctr, __ATOMIC_RELAXED, __HIP_MEMORY_SCOPE_AGENT) < 24u) { __builtin_amdgcn_s_sleep(4); if (++sp > (1u << 22)) break; }
                __builtin_amdgcn_fence(__ATOMIC_ACQUIRE, "agent"); asm volatile("s_waitcnt vmcnt(0)" ::: "memory"); }
            __syncthreads();
            kv_issue(p, t, tid, cur); }
        const float l2f = log2_gamma(p.ret_logit_f[h]), l2b = log2_gamma(p.ret_logit_b[h]);
        const bool seq = ck < 16;
        {
            const int j = tid >> 2, dg = tid & 3; float lo[8], hi[8];
            const unsigned aw[4] = {cur.ka.x, cur.ka.y, cur.ka.z, cur.ka.w}, bw[4] = {cur.kb.x, cur.kb.y, cur.kb.z, cur.kb.w};
#pragma unroll
            for (int e = 0; e < 4; ++e) { lo[2 * e] = bflo(aw[e]); lo[2 * e + 1] = bfhi(aw[e]); hi[2 * e] = bflo(bw[e]); hi[2 * e + 1] = bfhi(bw[e]); }
            if (seq) {
#pragma unroll
                for (int e = 0; e < 4; ++e) { const f32x4 cs = cur.rp[e];
                    float x1 = lo[2 * e], x2 = hi[2 * e]; lo[2 * e] = x1 * cs.x - x2 * cs.y; hi[2 * e] = x1 * cs.y + x2 * cs.x;
                    x1 = lo[2 * e + 1]; x2 = hi[2 * e + 1]; lo[2 * e + 1] = x1 * cs.z - x2 * cs.w; hi[2 * e + 1] = x1 * cs.w + x2 * cs.z; } }
            const float wf = 0.125f * exp2f(l2f * (float)(127 - j)), wb = 0.125f * exp2f(l2b * (float)j);
            u32x4 w;
            w.x = cvt_pk_bf16(lo[0] * wf, lo[1] * wf); w.y = cvt_pk_bf16(lo[2] * wf, lo[3] * wf); w.z = cvt_pk_bf16(lo[4] * wf, lo[5] * wf); w.w = cvt_pk_bf16(lo[6] * wf, lo[7] * wf); *(LAS u32x4*)(Kf + j * LDKR + 8 * dg) = w;
            w.x = cvt_pk_bf16(hi[0] * wf, hi[1] * wf); w.y = cvt_pk_bf16(hi[2] * wf, hi[3] * wf); w.z = cvt_pk_bf16(hi[4] * wf, hi[5] * wf); w.w = cvt_pk_bf16(hi[6] * wf, hi[7] * wf); *(LAS u32x4*)(Kf + j * LDKR + 32 + 8 * dg) = w;
            w.x = cvt_pk_bf16(lo[0] * wb, lo[1] * wb); w.y = cvt_pk_bf16(lo[2] * wb, lo[3] * wb); w.z = cvt_pk_bf16(lo[4] * wb, lo[5] * wb); w.w = cvt_pk_bf16(lo[6] * wb, lo[7] * wb); *(LAS u32x4*)(Kb + j * LDKR + 8 * dg) = w;
            w.x = cvt_pk_bf16(hi[0] * wb, hi[1] * wb); w.y = cvt_pk_bf16(hi[2] * wb, hi[3] * wb); w.z = cvt_pk_bf16(hi[4] * wb, hi[5] * wb); w.w = cvt_pk_bf16(hi[6] * wb, hi[7] * wb); *(LAS u32x4*)(Kb + j * LDKR + 32 + 8 * dg) = w;
        }
#pragma unroll
        for (int q = 0; q < 4; ++q) { const int pc = tid + 512 * q, j = pc >> 4, eg = pc & 15; *(LAS u32x4*)(Vr + j * LDVR + 8 * eg) = cur.v[q]; }
        if (t + G < 512) kv_issue(p, t + G, tid, cur);
        __syncthreads();
        {
            const int dir = wave >> 2, e0 = (wave & 3) * 32, fr = lane & 15, fq = lane >> 4;
            const LAS bf16* Kx = dir ? Kb : Kf;
            const int trow = 8 * fq + (fr >> 2), tcol = 4 * (fr & 3);
            f32x4 acc[2][4];
#pragma unroll
            for (int mt = 0; mt < 2; ++mt)
#pragma unroll
                for (int n = 0; n < 4; ++n) acc[mt][n] = (f32x4){0.f, 0.f, 0.f, 0.f};
#pragma unroll
            for (int ks = 0; ks < 4; ++ks) {
                bf16x8 af[2], bfr[4];
#pragma unroll
                for (int mt = 0; mt < 2; ++mt) { const LAS bf16* a = Vr + (32 * ks + trow) * LDVR + e0 + 16 * mt + tcol;
                    const s16x4 t0 = __builtin_amdgcn_ds_read_tr16_b64_v4i16((LAS s16x4*)a), t1 = __builtin_amdgcn_ds_read_tr16_b64_v4i16((LAS s16x4*)(a + 4 * LDVR));
                    af[mt] = (bf16x8){t0.x, t0.y, t0.z, t0.w, t1.x, t1.y, t1.z, t1.w}; }
#pragma unroll
                for (int n = 0; n < 4; ++n) { const LAS bf16* b = Kx + (32 * ks + trow) * LDKR + 16 * n + tcol;
                    const s16x4 t0 = __builtin_amdgcn_ds_read_tr16_b64_v4i16((LAS s16x4*)b), t1 = __builtin_amdgcn_ds_read_tr16_b64_v4i16((LAS s16x4*)(b + 4 * LDKR));
                    bfr[n] = (bf16x8){t0.x, t0.y, t0.z, t0.w, t1.x, t1.y, t1.z, t1.w}; }
#pragma unroll
                for (int mt = 0; mt < 2; ++mt)
#pragma unroll
                    for (int n = 0; n < 4; ++n) acc[mt][n] = __builtin_amdgcn_mfma_f32_16x16x32_bf16(af[mt], bfr[n], acc[mt][n], 0, 0, 0);
            }
            float* dst = KV + ((size_t)(bh * 18 + ck) * 2 + dir) * 8192;
#pragma unroll
            for (int mt = 0; mt < 2; ++mt)
#pragma unroll
                for (int n = 0; n < 4; ++n)
#pragma unroll
                    for (int r = 0; r < 4; ++r) __hip_atomic_store(dst + (e0 + 16 * mt + 4 * fq + r) * 64 + 16 * n + fr, acc[mt][n][r], __ATOMIC_RELAXED, __HIP_MEMORY_SCOPE_AGENT);
        }
        __syncthreads();
    }
}

__device__ __forceinline__ void phase2b(const Params& p) {
    const int half = gridDim.x >> 1; if ((int)blockIdx.x < half) return;
    const int gt = ((int)blockIdx.x - half) * 512 + threadIdx.x, NT = (gridDim.x - half) * 512;
    const float* KV = WSP(float, WS_KV); bf16* Sst = WSP(bf16, WS_SST);
    for (int it = gt; it < 64 * 1024; it += NT) {
        const int bhd = it >> 10, bh = bhd >> 1, dir = bhd & 1, h = bh & 3, off = (it & 1023) * 8;
        const float g128 = exp2f(log2_gamma(dir ? p.ret_logit_b[h] : p.ret_logit_f[h]) * 128.f);
        const float* base = KV + ((size_t)bh * 18 * 2 + dir) * 8192 + off;
        f32x4 v[18][2];
#pragma unroll
        for (int ck = 0; ck < 18; ++ck) { v[ck][0] = *(const f32x4*)(base + (size_t)ck * 2 * 8192); v[ck][1] = *(const f32x4*)(base + (size_t)ck * 2 * 8192 + 4); }
        f32x4 s0, s1;
        if (dir == 0) { s0 = v[16][0] * g128 + v[17][0]; s1 = v[16][1] * g128 + v[17][1]; } else { s0 = v[16][0] + v[17][0] * g128; s1 = v[16][1] + v[17][1] * g128; }
#pragma unroll
        for (int i = 0; i < 16; ++i) { const int c = dir ? 15 - i : i;
            u32x4 w; w.x = cvt_pk_bf16(s0.x, s0.y); w.y = cvt_pk_bf16(s0.z, s0.w); w.z = cvt_pk_bf16(s1.x, s1.y); w.w = cvt_pk_bf16(s1.z, s1.w);
            *(u32x4*)(Sst + (((size_t)bh * 16 + c) * 2 + dir) * 8192 + off) = w;
            const f32x4 k0 = dir ? v[15 - i][0] : v[i][0], k1 = dir ? v[15 - i][1] : v[i][1];
            s0 = s0 * g128 + k0; s1 = s1 * g128 + k1; }
    }
}

constexpr int LDQ = 72, LDV = 136;
constexpr int R_Q = 0, R_K = R_Q + 128 * LDQ * 2, R_VT = R_K + 128 * LDQ * 2, R_SF = R_VT + 128 * LDV * 2, R_SB = R_SF + 128 * LDQ * 2, R_OS = R_SB + 128 * LDQ * 2, R_END = R_OS + 128 * LDV * 2;
static_assert(R_END <= LDS_BYTES, "retention LDS");
__device__ __forceinline__ void ret_task(const Params& p, LAS unsigned char* lds, int t) {
    const int tid = threadIdx.x, lane = tid & 63, wave = tid >> 6;
    LAS bf16* Qs = (LAS bf16*)(lds + R_Q); LAS bf16* Ks = (LAS bf16*)(lds + R_K); LAS bf16* vT = (LAS bf16*)(lds + R_VT);
    LAS bf16* SfT = (LAS bf16*)(lds + R_SF); LAS bf16* SbT = (LAS bf16*)(lds + R_SB); LAS bf16* Os = (LAS bf16*)(lds + R_OS);
    const bf16* qkvg = WSP(bf16, WS_QKVG); const f32x2* rope = WSP(f32x2, WS_ROPE); const float* KV = WSP(float, WS_KV); bf16* ycat = WSP(bf16, WS_YCAT);
    const int bh = t >> 4, c = t & 15, b = bh >> 2, h = bh & 3;
    const float l2f = log2_gamma(p.ret_logit_f[h]), l2b = log2_gamma(p.ret_logit_b[h]);
    const size_t tok0 = (size_t)b * SEQ + c * CH;
    u32x4 gpre[4];
#pragma unroll
    for (int q = 0; q < 4; ++q) { const int pc = tid + 512 * q; gpre[q] = *(const u32x4*)(qkvg + (tok0 + (pc >> 4)) * NREST + 1024 + h * DV + 8 * (pc & 15)); }
    {
        const int j = tid >> 2, dg = tid & 3; float lo[8], hi[8];
        const bf16* src = qkvg + (tok0 + j) * NREST + h * DK;
        load_qk_rope(src, 0, rope, c * CH + j, true, dg, 1.0f, lo, hi);
        u32x4 w; w.x = cvt_pk_bf16(lo[0], lo[1]); w.y = cvt_pk_bf16(lo[2], lo[3]); w.z = cvt_pk_bf16(lo[4], lo[5]); w.w = cvt_pk_bf16(lo[6], lo[7]); *(LAS u32x4*)(Qs + j * LDQ + 8 * dg) = w;
        w.x = cvt_pk_bf16(hi[0], hi[1]); w.y = cvt_pk_bf16(hi[2], hi[3]); w.z = cvt_pk_bf16(hi[4], hi[5]); w.w = cvt_pk_bf16(hi[6], hi[7]); *(LAS u32x4*)(Qs + j * LDQ + 32 + 8 * dg) = w;
        load_qk_rope(src + 256, 0, rope, c * CH + j, true, dg, 0.125f, lo, hi);
        w.x = cvt_pk_bf16(lo[0], lo[1]); w.y = cvt_pk_bf16(lo[2], lo[3]); w.z = cvt_pk_bf16(lo[4], lo[5]); w.w = cvt_pk_bf16(lo[6], lo[7]); *(LAS u32x4*)(Ks + j * LDQ + 8 * dg) = w;
        w.x = cvt_pk_bf16(hi[0], hi[1]); w.y = cvt_pk_bf16(hi[2], hi[3]); w.z = cvt_pk_bf16(hi[4], hi[5]); w.w = cvt_pk_bf16(hi[6], hi[7]); *(LAS u32x4*)(Ks + j * LDQ + 32 + 8 * dg) = w;
    }
#pragma unroll
    for (int q = 0; q < 4; ++q) {
        const int pc = tid + 512 * q, j = pc >> 4, eg = pc & 15;
        const u32x4 a = *(const u32x4*)(qkvg + (tok0 + j) * NREST + 512 + h * DV + 8 * eg); const unsigned aw[4] = {a.x, a.y, a.z, a.w};
#pragma unroll
        for (int e = 0; e < 4; ++e) { vT[(8 * eg + 2 * e) * LDV + (j ^ (eg << 3))] = (bf16)(aw[e] & 0xffffu); vT[(8 * eg + 2 * e + 1) * LDV + (j ^ (eg << 3))] = (bf16)(aw[e] >> 16); }
    }
    {
        const bf16* sst = WSP(bf16, WS_SST) + ((size_t)bh * 16 + c) * 2 * 8192;
#pragma unroll
        for (int q = 0; q < 2; ++q) { const int pc = tid + 512 * q, e = pc >> 3, d0 = (pc & 7) * 8;
            *(LAS u32x4*)(SfT + e * LDQ + d0) = *(const u32x4*)(sst + pc * 8);
            *(LAS u32x4*)(SbT + e * LDQ + d0) = *(const u32x4*)(sst + 8192 + pc * 8); }
    }
    __syncthreads();
    {
        const int fr = lane & 15, fq = lane >> 4, iloc = 16 * wave + fr;
        bf16x8 qf[2], qF[2], qB[2];
#pragma unroll
        for (int ks = 0; ks < 2; ++ks) qf[ks] = *(const LAS bf16x8*)(Qs + iloc * LDQ + 32 * ks + 8 * fq);
        {
            const float sF = exp2f(l2f * (float)(iloc + 1)), sB = exp2f(l2b * (float)(128 - iloc));
#pragma unroll
            for (int ks = 0; ks < 2; ++ks) { union { bf16x8 v; unsigned u[4]; } in, oF, oB; in.v = qf[ks];
#pragma unroll
                for (int e = 0; e < 4; ++e) { const float a = bflo(in.u[e]), bb = bfhi(in.u[e]); oF.u[e] = cvt_pk_bf16(a * sF, bb * sF); oB.u[e] = cvt_pk_bf16(a * sB, bb * sB); }
                qF[ks] = oF.v; qB[ks] = oB.v; }
        }
        f32x4 sacc[8];
#pragma unroll
        for (int jt = 0; jt < 8; ++jt) { sacc[jt] = (f32x4){0.f, 0.f, 0.f, 0.f};
#pragma unroll
            for (int ks = 0; ks < 2; ++ks) { const bf16x8 kf = *(const LAS bf16x8*)(Ks + (16 * jt + fr) * LDQ + 32 * ks + 8 * fq);
                sacc[jt] = __builtin_amdgcn_mfma_f32_16x16x32_bf16(kf, qf[ks], sacc[jt], 0, 0, 0); } }
        bf16x8 pf[4];
#pragma unroll
        for (int ks = 0; ks < 4; ++ks) { union { bf16x8 v; unsigned u[4]; } o;
#pragma unroll
            for (int half = 0; half < 2; ++half) { const int jt = 2 * ks + half; float pv[4];
#pragma unroll
                for (int r = 0; r < 4; ++r) { const int diff = iloc - (16 * jt + 4 * fq + r); const float dm = diff >= 0 ? exp2f(l2f * (float)diff) : exp2f(l2b * (float)(-diff)); pv[r] = sacc[jt][r] * dm; }
                o.u[2 * half] = cvt_pk_bf16(pv[0], pv[1]); o.u[2 * half + 1] = cvt_pk_bf16(pv[2], pv[3]); }
            pf[ks] = o.v; }
        f32x4 oacc[8];
#pragma unroll
        for (int nt = 0; nt < 8; ++nt) { oacc[nt] = (f32x4){0.f, 0.f, 0.f, 0.f};
            const LAS bf16* vrow = vT + (16 * nt + fr) * LDV; const int sw = (((16 * nt + fr) >> 3) & 15) << 3;
#pragma unroll
            for (int ks = 0; ks < 4; ++ks) { union { bf16x8 v; u32x2 h[2]; } bv; bv.h[0] = *(const LAS u32x2*)(vrow + ((32 * ks + 4 * fq) ^ sw)); bv.h[1] = *(const LAS u32x2*)(vrow + ((32 * ks + 16 + 4 * fq) ^ sw));
                oacc[nt] = __builtin_amdgcn_mfma_f32_16x16x32_bf16(pf[ks], bv.v, oacc[nt], 0, 0, 0); }
#pragma unroll
            for (int ks = 0; ks < 2; ++ks) { const bf16x8 sfv = *(const LAS bf16x8*)(SfT + (16 * nt + fr) * LDQ + 32 * ks + 8 * fq), sbv = *(const LAS bf16x8*)(SbT + (16 * nt + fr) * LDQ + 32 * ks + 8 * fq);
                oacc[nt] = __builtin_amdgcn_mfma_f32_16x16x32_bf16(qF[ks], sfv, oacc[nt], 0, 0, 0);
                oacc[nt] = __builtin_amdgcn_mfma_f32_16x16x32_bf16(qB[ks], sbv, oacc[nt], 0, 0, 0); } }
        float rs[4];
#pragma unroll
        for (int r = 0; r < 4; ++r) { float ss = 0.f;
#pragma unroll
            for (int nt = 0; nt < 8; ++nt) ss += oacc[nt][r] * oacc[nt][r];
            ss += __shfl_xor(ss, 1); ss += __shfl_xor(ss, 2); ss += __shfl_xor(ss, 4); ss += __shfl_xor(ss, 8);
            rs[r] = rsqrtf(ss * (1.0f / DV) + EPS); }
#pragma unroll
        for (int nt = 0; nt < 8; ++nt)
#pragma unroll
            for (int r = 0; r < 4; ++r) Os[(16 * wave + 4 * fq + r) * LDV + 16 * nt + fr] = f2bf(oacc[nt][r] * rs[r]);
    }
    __syncthreads();
#pragma unroll
    for (int q = 0; q < 4; ++q) {
        const int pc = tid + 512 * q, i = pc >> 4, eg = pc & 15;
        const u32x4 o = *(const LAS u32x4*)(Os + i * LDV + 8 * eg), g = gpre[q];
        const unsigned ow[4] = {o.x, o.y, o.z, o.w}, gw[4] = {g.x, g.y, g.z, g.w}; unsigned rw[4];
#pragma unroll
        for (int e = 0; e < 4; ++e) rw[e] = cvt_pk_bf16(silu_f(bflo(gw[e])) * bflo(ow[e]), silu_f(bfhi(gw[e])) * bfhi(ow[e]));
        *(u32x4*)(ycat + (tok0 + i) * DM + 512 + h * DV + 8 * eg) = (u32x4){rw[0], rw[1], rw[2], rw[3]};
    }
    __syncthreads();
}

#ifndef MK_HYLOOP2
#define MK_HYLOOP2 0
#endif
constexpr int U_ROWB = 80, U_BLKB = 8 * U_ROWB, U_PAD = 7, U_BYTES = (64 + 2 * U_PAD) * U_BLKB;
constexpr int CP_STRIDE = 8192 + 64, H_U = 0, H_CP = U_BYTES, H_KS = H_CP + 8 * CP_STRIDE, H_END = H_KS + 8192 + 16;
static_assert(H_END <= LDS_BYTES && (H_CP % 16) == 0 && (H_KS % 16) == 0, "hyena LDS");
__device__ __forceinline__ void hyena_task(const Params& p, LAS unsigned char* lds, int ch) {
    const int tid = threadIdx.x, lane = tid & 63, wave = tid >> 6;
    const bf16* zT = WSP(bf16, WS_ZT); const bf16* kern = WSP(bf16, WS_FILT); bf16* yT = WSP(bf16, WS_YT);
    for (int i = tid; i < 2 * U_PAD * U_BLKB / 16; i += 512) { const int off = (i < U_PAD * U_BLKB / 16) ? i * 16 : (64 + U_PAD) * U_BLKB + (i - U_PAD * U_BLKB / 16) * 16; *(LAS u32x4*)(lds + H_U + off) = (u32x4){0u, 0u, 0u, 0u}; }
    {
        const float w0 = p.hy_conv_w[ch], w1 = p.hy_conv_w[HYC + ch], w2 = p.hy_conv_w[2 * HYC + ch], cb = p.hy_conv_b[ch];
        const bf16* zr = zT + (size_t)ch * M_TOK;
#pragma unroll
        for (int q = 0; q < 4; ++q) { const int pc = tid + 512 * q, b = pc >> 8, t0 = 8 * (pc & 255);
            const bf16* s = zr + b * SEQ + t0; const u32x4 a = *(const u32x4*)s; const unsigned aw[4] = {a.x, a.y, a.z, a.w};
            const float xl_ = bf2f(s[t0 > 0 ? -1 : 0]), xr_ = bf2f(s[t0 + 8 < SEQ ? 8 : 7]);
            float xv[10]; xv[0] = t0 > 0 ? xl_ : 0.f; xv[9] = t0 + 8 < SEQ ? xr_ : 0.f;
#pragma unroll
            for (int e = 0; e < 4; ++e) { xv[1 + 2 * e] = bflo(aw[e]); xv[2 + 2 * e] = bfhi(aw[e]); }
            float o[8];
#pragma unroll
            for (int e = 0; e < 8; ++e) o[e] = w0 * xv[e] + w1 * xv[e + 1] + w2 * xv[e + 2] + cb;
            u32x4 w; w.x = cvt_pk_bf16(o[0], o[1]); w.y = cvt_pk_bf16(o[2], o[3]); w.z = cvt_pk_bf16(o[4], o[5]); w.w = cvt_pk_bf16(o[6], o[7]);
            *(LAS u32x4*)(lds + H_U + ((t0 >> 5) + U_PAD) * U_BLKB + b * U_ROWB + (t0 & 31) * 2) = w; }
    }
    const int a_ = lane & 31, hh = lane >> 5;
    unsigned ypk[2][8];
    for (int o = 0; o < 2; ++o) {
        { const u32x4 kw = *(const u32x4*)(kern + ((size_t)(o * 512 + ch)) * 4096 + tid * 8);
          u32x4 rv; rv.x = (kw.w >> 16) | (kw.w << 16); rv.y = (kw.z >> 16) | (kw.z << 16); rv.z = (kw.y >> 16) | (kw.y << 16); rv.w = (kw.x >> 16) | (kw.x << 16);
          *(LAS u32x4*)(lds + H_KS + (511 - tid) * 16) = rv;
          if (tid == 0) *(LAS u32x4*)(lds + H_KS + 8192) = (u32x4){0u, 0u, 0u, 0u}; }
        __syncthreads();
        {
            const u32x4 lo = *(const LAS u32x4*)(lds + H_KS + tid * 16), hi = *(const LAS u32x4*)(lds + H_KS + tid * 16 + 16);
            const unsigned w[8] = {lo.x, lo.y, lo.z, lo.w, hi.x, hi.y, hi.z, hi.w};
#pragma unroll
            for (int s = 0; s < 8; ++s) { unsigned ow[4];
#pragma unroll
                for (int i = 0; i < 4; ++i) ow[i] = (s & 1) ? __builtin_amdgcn_alignbit(w[i + (s + 1) / 2], w[i + (s - 1) / 2], 16) : w[i + s / 2];
                *(LAS u32x4*)(lds + H_CP + s * CP_STRIDE + tid * 16) = (u32x4){ow[0], ow[1], ow[2], ow[3]}; }
        }
        __syncthreads();
        f32x16 acc[2];
#pragma unroll
        for (int i = 0; i < 16; ++i) { acc[0][i] = 0.f; acc[1][i] = 0.f; }
        u32x2 gxw[2][4]; float gxl[2][4], gxr[2][4];
        {
            const bf16* xr = zT + (size_t)(512 * (o + 1) + ch) * M_TOK + (lane & 7) * SEQ;
#pragma unroll
            for (int I2 = 0; I2 < 2; ++I2)
#pragma unroll
                for (int g4 = 0; g4 < 4; ++g4) { const int pos = 32 * (4 * (2 * wave + I2) + (a_ >> 3)) + 8 * g4 + 4 * hh;
                    gxw[I2][g4] = *(const u32x2*)(xr + pos); gxl[I2][g4] = bf2f(xr[pos > 0 ? pos - 1 : 0]); gxr[I2][g4] = bf2f(xr[pos + 4 < SEQ ? pos + 4 : pos]); }
        }
        {
            const int sg = 7 - (a_ & 7);
            const int abase = H_CP + sg * CP_STRIDE + (255 - (a_ >> 3) + hh) * 16;
            const int bbase = H_U + a_ * U_ROWB + 16 * hh + (8 * wave + U_PAD) * U_BLKB;
            const int dlo = 8 * wave - 63;
            bf16x8 rb[4][2];
#pragma unroll
            for (int s = 0; s < 4; ++s) { const LAS unsigned char* bp = lds + bbase - U_BLKB * (dlo - 4 + s); rb[s][0] = *(const LAS bf16x8*)bp; rb[s][1] = *(const LAS bf16x8*)(bp + 32); }
            bf16x8 ca0, ca1, cn0, cn1;
            { const LAS unsigned char* ap = lds + abase - 64 * dlo; const LAS unsigned char* bp = lds + bbase - U_BLKB * dlo;
              ca0 = *(const LAS bf16x8*)ap; ca1 = *(const LAS bf16x8*)(ap + 32); cn0 = *(const LAS bf16x8*)bp; cn1 = *(const LAS bf16x8*)(bp + 32); }
#define HY_STEP(d_, s_, PF) do { const int d = (d_); bf16x8 na0, na1, nn0, nn1; \
                if (PF) { const LAS unsigned char* ap = lds + abase - 64 * (d + 1); const LAS unsigned char* bp = lds + bbase - U_BLKB * (d + 1); \
                    na0 = *(const LAS bf16x8*)ap; na1 = *(const LAS bf16x8*)(ap + 32); nn0 = *(const LAS bf16x8*)bp; nn1 = *(const LAS bf16x8*)(bp + 32); } \
                acc[1] = __builtin_amdgcn_mfma_f32_32x32x16_bf16(ca0, rb[s_][0], acc[1], 0, 0, 0); \
                acc[0] = __builtin_amdgcn_mfma_f32_32x32x16_bf16(ca0, cn0, acc[0], 0, 0, 0); \
                acc[1] = __builtin_amdgcn_mfma_f32_32x32x16_bf16(ca1, rb[s_][1], acc[1], 0, 0, 0); \
                acc[0] = __builtin_amdgcn_mfma_f32_32x32x16_bf16(ca1, cn1, acc[0], 0, 0, 0); \
                rb[s_][0] = cn0; rb[s_][1] = cn1; if (PF) { ca0 = na0; ca1 = na1; cn0 = nn0; cn1 = nn1; } } while (0)
            for (int dd = 0; dd < 68; dd += 4) { HY_STEP(dlo + dd, 0, true); HY_STEP(dlo + dd + 1, 1, true); HY_STEP(dlo + dd + 2, 2, true); HY_STEP(dlo + dd + 3, 3, true); }
            HY_STEP(dlo + 68, 0, true); HY_STEP(dlo + 69, 1, true); HY_STEP(dlo + 70, 2, false);
#if MK_HYLOOP2
            { f32x16 sv0 = acc[0], sv1 = acc[1];
              { const LAS unsigned char* ap = lds + abase - 64 * dlo; const LAS unsigned char* bp = lds + bbase - U_BLKB * dlo;
                ca0 = *(const LAS bf16x8*)ap; ca1 = *(const LAS bf16x8*)(ap + 32); cn0 = *(const LAS bf16x8*)bp; cn1 = *(const LAS bf16x8*)(bp + 32); }
              for (int dd = 0; dd < 68; dd += 4) { HY_STEP(dlo + dd, 0, true); HY_STEP(dlo + dd + 1, 1, true); HY_STEP(dlo + dd + 2, 2, true); HY_STEP(dlo + dd + 3, 3, true); }
              HY_STEP(dlo + 68, 0, true); HY_STEP(dlo + 69, 1, true); HY_STEP(dlo + 70, 2, false);
#pragma unroll
              for (int i = 0; i < 16; ++i) { acc[0][i] = sv0[i] + 0.0f * acc[0][i]; acc[1][i] = sv1[i] + 0.0f * acc[1][i]; } }
#endif
#undef HY_STEP
        }
        {
            const int b = lane & 7, jj = a_ >> 3, colx = 512 * (o + 1) + ch;
            const float w0 = p.hy_conv_w[colx], w1 = p.hy_conv_w[HYC + colx], w2 = p.hy_conv_w[2 * HYC + colx], cb = p.hy_conv_b[colx], sk = p.hy_bias[o * 512 + ch];
            const bf16* xr = zT + (size_t)colx * M_TOK + b * SEQ;
#pragma unroll
            for (int I2 = 0; I2 < 2; ++I2) { const int blk = 4 * (2 * wave + I2) + jj;
#pragma unroll
                for (int g4 = 0; g4 < 4; ++g4) { const int aa = 8 * g4 + 4 * hh, pos = 32 * blk + aa;
                    const u32x2 uw = *(const LAS u32x2*)(lds + H_U + (blk + U_PAD) * U_BLKB + b * U_ROWB + aa * 2);
                    const u32x2 xw = gxw[I2][g4];
                    float xv[6]; xv[0] = pos > 0 ? gxl[I2][g4] : 0.f; xv[5] = pos + 4 < SEQ ? gxr[I2][g4] : 0.f;
                    xv[1] = bflo(xw.x); xv[2] = bfhi(xw.x); xv[3] = bflo(xw.y); xv[4] = bfhi(xw.y);
                    const float uv[4] = {bflo(uw.x), bfhi(uw.x), bflo(uw.y), bfhi(uw.y)}; float y[4];
#pragma unroll
                    for (int e = 0; e < 4; ++e) { const float gate = w0 * xv[e] + w1 * xv[e + 1] + w2 * xv[e + 2] + cb; y[e] = gate * (acc[I2][4 * g4 + e] + sk * uv[e]); }
                    const unsigned p0 = cvt_pk_bf16(y[0], y[1]), p1 = cvt_pk_bf16(y[2], y[3]);
                    if (o == 0) { ypk[I2][2 * g4] = p0; ypk[I2][2 * g4 + 1] = p1; }
                    else *(u32x2*)(yT + (size_t)ch * M_TOK + b * SEQ + pos) = (u32x2){p0, p1}; } }
        }
        __syncthreads();
        if (o == 0) {
            const int b = lane & 7, jj = a_ >> 3;
#pragma unroll
            for (int I2 = 0; I2 < 2; ++I2) { const int blk = 4 * (2 * wave + I2) + jj;
#pragma unroll
                for (int g4 = 0; g4 < 4; ++g4) { const int aa = 8 * g4 + 4 * hh;
                    *(LAS u32x2*)(lds + H_U + (blk + U_PAD) * U_BLKB + b * U_ROWB + aa * 2) = (u32x2){ypk[I2][2 * g4], ypk[I2][2 * g4 + 1]}; } }
        }
    }
    __syncthreads();
}

__device__ __forceinline__ void phase3c(const Params& p, LAS unsigned char* lds) {
    const int tid = threadIdx.x, lane = tid & 63, wave = tid >> 6, G = gridDim.x;
    LAS bf16* tl = (LAS bf16*)(lds + wave * 16384);
    const bf16* yT = WSP(bf16, WS_YT); bf16* ycat = WSP(bf16, WS_YCAT);
    for (int it = blockIdx.x * 8 + wave; it < 8 * 256; it += G * 8) {
        const int cb = it >> 8, tb = it & 255;
#pragma unroll
        for (int q = 0; q < 8; ++q) { const int pc = lane + 64 * q, r = pc >> 3, c8 = pc & 7;
            *(LAS u32x4*)(tl + r * 72 + 8 * c8) = *(const u32x4*)(yT + (size_t)(64 * cb + r) * M_TOK + 64 * tb + 8 * c8); }
        LDS_WAIT(); asm volatile("" ::: "memory");
#pragma unroll
        for (int q = 0; q < 8; ++q) { const int pc = lane + 64 * q, tk = pc >> 3, c8 = pc & 7; unsigned w[4];
#pragma unroll
            for (int e = 0; e < 4; ++e) w[e] = (unsigned)tl[(8 * c8 + 2 * e) * 72 + tk] | ((unsigned)tl[(8 * c8 + 2 * e + 1) * 72 + tk] << 16);
            *(u32x4*)(ycat + (size_t)(64 * tb + tk) * DM + 64 * cb + 8 * c8) = (u32x4){w[0], w[1], w[2], w[3]}; }
        LDS_WAIT(); asm volatile("" ::: "memory");
    }
}

__device__ __forceinline__ void p6_row(const u32x4 (&v)[3], const u32x4 (&g)[3], const float (&wv)[3][8], const float (&wg)[3][8], const float (&bvv)[8], const float (&bgg)[8], bf16* dst) {
    unsigned ow[4];
#pragma unroll
    for (int e = 0; e < 4; ++e) {
        float v0 = bvv[2 * e], v1 = bvv[2 * e + 1], q0 = bgg[2 * e], q1 = bgg[2 * e + 1];
#pragma unroll
        for (int k = 0; k < 3; ++k) { const unsigned a = v[k][e], b = g[k][e];
            v0 += wv[k][2 * e] * bflo(a); v1 += wv[k][2 * e + 1] * bfhi(a); q0 += wg[k][2 * e] * bflo(b); q1 += wg[k][2 * e + 1] * bfhi(b); }
        ow[e] = cvt_pk_bf16(silu_f(q0) * v0, silu_f(q1) * v1); }
    *(u32x4*)dst = (u32x4){ow[0], ow[1], ow[2], ow[3]};
}
__device__ __forceinline__ void ffn_edge_rows(const Params& p, int pm) {
    bf16* act = WSP(bf16, WS_APRE); const bf16* halo4 = WSP(bf16, WS_HALO);
    for (int t = threadIdx.x; t < 704; t += 512) {
        const int which = t / 352, cg = t % 352, pn = cg >> 4, j0 = (cg & 15) * 8;
        const int cv = 256 * pn + j0, cgt = cv + 128, ov = 128 * pn + j0, og = DFF + ov;
        float wv[3][8], wg[3][8], bvv[8], bgg[8];
#pragma unroll
        for (int e = 0; e < 8; ++e) { bvv[e] = p.ffn_conv_b[ov + e]; bgg[e] = p.ffn_conv_b[og + e];
#pragma unroll
            for (int k = 0; k < 3; ++k) { wv[k][e] = p.ffn_conv_w[k * NUP + ov + e]; wg[k][e] = p.ffn_conv_w[k * NUP + og + e]; } }
        const u32x4 zero = (u32x4){0u, 0u, 0u, 0u};
        const bf16* hm = halo4 + (size_t)pm * 4 * NUP;
        u32x4 v3[3], g3[3];
        if (which == 0) {
            if (pm & 7) { v3[0] = *(const u32x4*)(hm - NUP + cv); g3[0] = *(const u32x4*)(hm - NUP + cgt); } else { v3[0] = zero; g3[0] = zero; }
            v3[1] = *(const u32x4*)(hm + cv); g3[1] = *(const u32x4*)(hm + cgt); v3[2] = *(const u32x4*)(hm + NUP + cv); g3[2] = *(const u32x4*)(hm + NUP + cgt);
        } else {
            v3[0] = *(const u32x4*)(hm + 2 * NUP + cv); g3[0] = *(const u32x4*)(hm + 2 * NUP + cgt); v3[1] = *(const u32x4*)(hm + 3 * NUP + cv); g3[1] = *(const u32x4*)(hm + 3 * NUP + cgt);
            if ((pm & 7) != 7) { v3[2] = *(const u32x4*)(hm + 4 * NUP + cv); g3[2] = *(const u32x4*)(hm + 4 * NUP + cgt); } else { v3[2] = zero; g3[2] = zero; }
        }
        p6_row(v3, g3, wv, wg, bvv, bgg, act + (size_t)(256 * pm + (which ? 255 : 0)) * DFF + ov);
    }
}

__device__ __forceinline__ void phase8(const Params& p, float* wout) {
    const int tid = threadIdx.x, lane = tid & 63, wave = tid >> 6, G = gridDim.x;
    const float* ssq = WSP(float, WS_SUMSQ) + M_TOK;
    for (int m = blockIdx.x * 8 + wave; m < M_TOK; m += G * 8) {
        const float rs = rsqrtf(ssq[m] * (1.0f / DM) + EPS); f32x4* row = (f32x4*)(p.out + (size_t)m * DM);
        f32x4* wrow = (f32x4*)(wout + (size_t)m * DM);
#pragma unroll
        for (int j = 0; j < 4; ++j) { const int c4 = lane + 64 * j; wrow[c4] = row[c4] * rs * ((const f32x4*)p.norm_f)[c4]; }
    }
}
#ifndef MK_DEBUG
#define MK_DEBUG 0
#endif
#ifndef MK_TIMING
#define MK_TIMING 0
#endif
#ifndef MK_KA
#define MK_KA 0
#define MK_KB 1
#endif
constexpr size_t WS_TS = 25 * MiB + 900 * 1024;
constexpr size_t WS_BAR = WS_BAR_BASE;
constexpr int LDS_MISC = LDS_BYTES - 64;
#define XB_TMO      128
#define XB_XCNT(j)  (256  + 64 * (j))
#define XB_XSUB(j)  (1280 + 64 * (j))
#define XB_XGEN(j)  (2304 + 64 * (j))
#define XB_TOP      3328
#define XB_TOPGEN   3392
#define XCD_BAR_WORDS 3456
#define XB_SPIN_CAP (1u << 22)
__device__ __forceinline__ unsigned xb_ld(unsigned* p)              { return __hip_atomic_load(p, __ATOMIC_RELAXED, __HIP_MEMORY_SCOPE_AGENT); }
__device__ __forceinline__ unsigned xb_add(unsigned* p, unsigned v) { return __hip_atomic_fetch_add(p, v, __ATOMIC_RELAXED, __HIP_MEMORY_SCOPE_AGENT); }
__device__ __forceinline__ unsigned xb_xcc_id() { return (unsigned)__builtin_amdgcn_s_getreg((3 << 11) | 20) & 0xFu; }
#define XB_SPIN(cond, bar) do { unsigned _sp = 0; while (cond) { __builtin_amdgcn_s_sleep(1); \
    if ((++_sp & 255u) == 0u) { if (xb_ld(&(bar)[XB_TMO])) break; if (_sp > XB_SPIN_CAP) { atomicAdd(&(bar)[XB_TMO], 1u); break; } } } } while (0)
struct XcdBarrier { unsigned* bar; unsigned x; volatile LAS unsigned* st; };
__device__ __forceinline__ XcdBarrier xcd_barrier_post(unsigned* bar, volatile LAS unsigned* st) {
    XcdBarrier b; b.bar = bar; b.x = xb_xcc_id(); b.st = st;
    if (threadIdx.x == 0) (void)xb_add(&bar[XB_XCNT(b.x)], 1u);
    return b;
}
__device__ __forceinline__ void xcd_barrier_complete(unsigned* bar, unsigned x, unsigned& nloc, unsigned& nx) {
    const unsigned G = gridDim.x * gridDim.y * gridDim.z;
    unsigned sum, cnt, mine, sp = 0u;
    for (;;) {
        sum = 0u; cnt = 0u; mine = 0u;
#pragma unroll
        for (unsigned j = 0; j < 16; ++j) { const unsigned c = xb_ld(&bar[XB_XCNT(j)]); sum += c; cnt += (c > 0u) ? 1u : 0u; mine = (j == x) ? c : mine; }
        if (sum == G) break;
        __builtin_amdgcn_s_sleep(1);
        if ((++sp & 255u) == 0u) { if (xb_ld(&bar[XB_TMO])) break; if (sp > XB_SPIN_CAP) { atomicAdd(&bar[XB_TMO], 1u); break; } }
    }
    nloc = mine > 0u ? mine : 1u; nx = cnt > 0u ? cnt : 1u;
}
__device__ __forceinline__ void xcd_barrier(const XcdBarrier& b) {
    asm volatile("s_waitcnt vmcnt(0)" ::: "memory");
    __syncthreads();
    if (threadIdx.x == 0) {
        unsigned* bar = b.bar;
        __builtin_amdgcn_s_waitcnt(0);
        unsigned nloc = b.st[0], nx = b.st[1];
        if (nloc == 0u) { xcd_barrier_complete(bar, b.x, nloc, nx); b.st[0] = nloc; b.st[1] = nx; }
        const unsigned old = xb_add(&bar[XB_XSUB(b.x)], 1u);
        const unsigned gen = old / nloc;
        if (old + 1u == (gen + 1u) * nloc) {
            __builtin_amdgcn_fence(__ATOMIC_RELEASE, "agent");
            asm volatile("s_waitcnt vmcnt(0)" ::: "memory");
            const unsigned og = xb_add(&bar[XB_TOP], 1u);
            const unsigned tg = og / nx;
            if (og + 1u == (tg + 1u) * nx) xb_add(&bar[XB_TOPGEN], 1u);
            else XB_SPIN(xb_ld(&bar[XB_TOPGEN]) == tg, bar);
            __builtin_amdgcn_fence(__ATOMIC_ACQUIRE, "agent");
            xb_add(&bar[XB_XGEN(b.x)], 1u);
            asm volatile("s_waitcnt vmcnt(0)" ::: "memory");
        } else {
            XB_SPIN(xb_ld(&bar[XB_XGEN(b.x)]) == gen, bar);
            __builtin_amdgcn_fence(__ATOMIC_ACQUIRE, "agent");
            asm volatile("s_waitcnt vmcnt(0)" ::: "memory");
        }
    }
    __syncthreads();
}
#ifndef MK_CGSYNC
#define MK_CGSYNC 0
#endif
#ifndef MK_REP_P0A
#define MK_REP_P0A 1
#endif
#ifndef MK_REP_P0B
#define MK_REP_P0B 1
#endif
#ifndef MK_REP_P2
#define MK_REP_P2 1
#endif
#ifndef MK_REP_P3C
#define MK_REP_P3C 1
#endif
#ifndef MK_REP_P5
#define MK_REP_P5 1
#endif
#ifndef MK_REP_P56
#define MK_REP_P56 1
#endif
#ifndef MK_REP_P1
#define MK_REP_P1 1
#endif
#ifndef MK_REP_CTX
#define MK_REP_CTX 1
#endif
#ifndef MK_REP_P4
#define MK_REP_P4 1
#endif
#ifndef MK_REP_P7
#define MK_REP_P7 1
#endif
#ifndef MK_REP_P8
#define MK_REP_P8 1
#endif
#ifndef MK_PASSES
#define MK_PASSES 1
#endif
#ifndef MK_TILESYNC
#define MK_TILESYNC 0
#endif
#ifndef MK_P5_SP2
#define MK_P5_SP2 1
#endif
#ifndef MK_REP_HY
#define MK_REP_HY 1
#endif
#ifndef MK_REP_RET
#define MK_REP_RET 1
#endif
#ifndef MK_EXTRA_SYNC
#define MK_EXTRA_SYNC 0
#endif
#ifndef MK_MULTI
#define MK_MULTI 0
#endif
constexpr int N_PHASES = 9;
__global__ void __launch_bounds__(512, 2) fwd_kernel(Params p) {
    extern __shared__ __attribute__((aligned(16))) unsigned char lds_raw[];
    LAS unsigned char* lds = (LAS unsigned char*)lds_raw;
    cg::grid_group grid = cg::this_grid();
    const int G = gridDim.x, bx = blockIdx.x;
#define IN(k) (p.ph_lo <= (k) && (k) < p.ph_hi)
    if (threadIdx.x < 2) ((volatile LAS unsigned*)(lds + LDS_MISC))[threadIdx.x] = 0u;
    __syncthreads();
    const bool TILE_SYNC = (G == 256) && MK_TILESYNC; int tile_pm, tile_pn; pg8::order_tile<64, 4>(bx & 255, tile_pm, tile_pn);
    const XcdBarrier xbar = xcd_barrier_post(WSP(unsigned, WS_BAR), (volatile LAS unsigned*)(lds + LDS_MISC));
    if (p.ph_hi < 0) grid.sync();
#define SEAM(k) do { if (IN(k) && IN((k) + 1)) { if (MK_CGSYNC) grid.sync(); else xcd_barrier(xbar); } } while (0)
#if MK_DEBUG
#define DBG(call) do { call; grid.sync(); } while (0)
    if (bx == 0 && threadIdx.x < 16) WSP(unsigned, WS_DBG)[threadIdx.x] = 0u;
#else
#define DBG(call) do { } while (0)
#endif
#if MK_TIMING
#define STAMP(k) do { if (bx == 0 && threadIdx.x == 0) WSP(unsigned long long, WS_TS)[k] = __builtin_amdgcn_s_memrealtime(); } while (0)
#else
#define STAMP(k) do { } while (0)
#endif
    STAMP(0);
    if (IN(0)) for (int rep = 0; rep < MK_REP_P0A; ++rep) { phase0a(p, lds); __syncthreads(); }
    STAMP(1);
    DBG(chk_p0a(p));
    if (IN(1)) { EpiP1 E0{WSP(bf16, WS_ZT), WSP(bf16, WS_QKVG), WSP(bf16, WS_UC)}; phase0b<EpiP1>(p, lds, E0); }
    SEAM(1); STAMP(2);
    if (IN(2)) {
        pg8::Gemm g{DM, DM, DM, 256};
        SchedP1 S{(const char*)WSP(bf16, WS_WINT), (const char*)WSP(bf16, WS_H), (const char*)WSP(bf16, WS_HC), G, bx};
        EpiP1 E{WSP(bf16, WS_ZT), WSP(bf16, WS_QKVG), WSP(bf16, WS_UC)};
        for (int rep = 0; rep < MK_REP_P1; ++rep) pg8::gemm_phase<EpiP1, SchedP1>(lds, g, S, E);
    }
    SEAM(2); STAMP(3);
    DBG(chk_p1(p));
    if (IN(3)) {
        if (bx >= 64 && bx < 88) {
            int pm, pn; pg8::order_tile<8, 3>(bx - 64, pm, pn);
            pg8::Gemm g{DM, DM, DM, 256};
            SchedOne S1{(const char*)WSP(bf16, WS_HC) + (size_t)pm * 256 * DM * 2, (const char*)WSP(bf16, WS_WINT) + (size_t)(7 + pn) * 256 * DM * 2, pm, pn, 2};
            EpiP1 E1{WSP(bf16, WS_ZT), WSP(bf16, WS_QKVG), WSP(bf16, WS_UC)};
            pg8::gemm_phase<EpiP1, SchedOne>(lds, g, S1, E1);
            asm volatile("s_waitcnt vmcnt(0)" ::: "memory"); __syncthreads();
            if (threadIdx.x == 0) { __builtin_amdgcn_fence(__ATOMIC_RELEASE, "agent"); asm volatile("s_waitcnt vmcnt(0)" ::: "memory");
                __hip_atomic_fetch_add(WSP(unsigned, WS_ROWCTR), 1u, __ATOMIC_RELAXED, __HIP_MEMORY_SCOPE_AGENT); }
        }
        for (int rep = 0; rep < MK_REP_P2; ++rep) phase2(p, lds);
        asm volatile("s_waitcnt vmcnt(0)" ::: "memory"); __syncthreads();
        if (threadIdx.x == 0) __hip_atomic_fetch_add(WSP(unsigned, WS_CNT5), 1u, __ATOMIC_RELAXED, __HIP_MEMORY_SCOPE_AGENT);
        for (int rep = 0; rep < MK_REP_HY; ++rep) for (int t = bx; t < 512; t += G) hyena_task(p, lds, t);
        if (bx >= 88) transposes_late(p, lds, (bx - 88) * 8 + (threadIdx.x >> 6), (G - 88) * 8);
        tile_wait(WSP(unsigned, WS_CNT5), nullptr, nullptr, (unsigned)G);
        phase2b(p);
    }
    SEAM(3); STAMP(4);
    if (IN(4)) {
        bias2_rows(p);
        for (int rep = 0; rep < MK_REP_P3C; ++rep) phase3c(p, lds);
        __syncthreads();
    }
    STAMP(5);
    if (IN(5)) {
        for (int rep = 0; rep < MK_REP_RET; ++rep) for (int t = bx; t < 512; t += G) ret_task(p, lds, t);
        for (int rep = 0; rep < MK_EXTRA_SYNC; ++rep) xcd_barrier(xbar);
    }
    SEAM(5); STAMP(6);
    DBG(chk_p3(p));
    if (IN(6)) {
        pg8::Gemm g{DM, DM, DM, 256};
        SchedPlain<64, 4> S{(const char*)WSP(bf16, WS_YCAT), (const char*)WSP(bf16, WS_WOUTT), (size_t)256 * DM * 2, (size_t)256 * DM * 2, G, bx};
        EpiP4 E{p.x, WSP(bf16, WS_X1B), WSP(bf16, WS_A2), WSP(float, WS_MOD), p.norm2, WSP(float, WS_SUMSQ)};
        pg8::gemm_phase<EpiP4, SchedPlain<64, 4>>(lds, g, S, E);
        if (TILE_SYNC) tile_publish(WSP(unsigned, WS_CNT4) + 16 * tile_pm);
    }
    if (!TILE_SYNC) SEAM(6); STAMP(7);
    DBG(chk_p4(p));
    if (IN(7)) {
        if (TILE_SYNC) tile_wait(WSP(unsigned, WS_CNT4) + 16 * tile_pm, nullptr, nullptr, 4u);
        pg8::Gemm g{DM, DM, DM, 256};
        SchedPlain<64, 22> S{(const char*)WSP(bf16, WS_A2), (const char*)WSP(bf16, WS_WUPT), (size_t)256 * DM * 2, (size_t)256 * DM * 2, G, bx};
        EpiP5 E{WSP(bf16, WS_APRE), WSP(bf16, WS_HALO), WSP(float, WS_BIAS2), WSP(float, WS_SUMSQ), p.ffn_conv_w, p.ffn_conv_b};
        for (int rep = 0; rep < MK_REP_P5; ++rep) pg8::gemm_phase<EpiP5, SchedPlain<64, 22>, true, MK_P5_SP2>(lds, g, S, E);
        if (TILE_SYNC) tile_publish(WSP(unsigned, WS_CNT5) + 16 * tile_pm);
    }
    if (!TILE_SYNC) SEAM(7); STAMP(8);
    if (IN(8)) {
        pg8::Gemm g{DFF, DFF, DFF, 256};
        SchedPlain<64, 4> S{(const char*)WSP(bf16, WS_APRE), (const char*)WSP(bf16, WS_WDNT), (size_t)256 * DFF * 2, (size_t)256 * DFF * 2, G, bx};
        if (TILE_SYNC) { unsigned* c5 = WSP(unsigned, WS_CNT5);
            tile_wait(c5 + 16 * tile_pm, (tile_pm & 7) ? c5 + 16 * (tile_pm - 1) : nullptr, (tile_pm & 7) != 7 ? c5 + 16 * (tile_pm + 1) : nullptr, 4u); }
        { pg8::Unit u0; if (S.next(0, u0)) ffn_edge_rows(p, u0.pm); asm volatile("s_waitcnt vmcnt(0)" ::: "memory"); __syncthreads(); }
        EpiP7 E{p.out, WSP(bf16, WS_X1B), WSP(float, WS_MOD), p.norm_f, WSP(float, WS_XCH), WSP(unsigned, WS_CNT)};
        pg8::gemm_phase<EpiP7, SchedPlain<64, 4>>(lds, g, S, E);
    }
#if MK_TIMING
    xcd_barrier(xbar);
    if (bx == 0 && threadIdx.x == 0) { const unsigned long long* ts = WSP(unsigned long long, WS_TS); const unsigned long long tend = __builtin_amdgcn_s_memrealtime();
        const float da = (float)((MK_KA == 8 ? tend : ts[MK_KA + 1]) - ts[MK_KA]) * 0.01f, db = (float)((MK_KB == 8 ? tend : ts[MK_KB + 1]) - ts[MK_KB]) * 0.01f;
        const float qa = 8.f * floorf(da / 8.f + 0.5f), qb = 8.f * floorf(db / 8.f + 0.5f);
        p.out[0] = 100.f * qa; const int n = 100 * (int)qb; for (int i = 1; i <= n; ++i) p.out[i] = 1000.f; }
#endif
#if MK_DEBUG
    grid.sync(); chk_end(p, lds); grid.sync(); dbg_emit(p);
#endif
#undef IN
#undef SEAM
}

extern "C" void kernel_launch(void* const* d_in, const int* in_sizes, int n_in, void* d_out, int out_size, void* d_ws, size_t ws_size, hipStream_t stream) {
    static int grid = 0;
    if (grid == 0) {
        if (n_in != 27 || out_size != M_TOK * DM || ws_size < WS_END) { fprintf(stderr, "kernel_launch: unexpected shapes (n_in %d out %d ws %zu)\n", n_in, out_size, ws_size); grid = -1; return; }
        int dev = 0, cus = 0, per_cu = 0;
        if (hipGetDevice(&dev) != hipSuccess || hipDeviceGetAttribute(&cus, hipDeviceAttributeMultiprocessorCount, dev) != hipSuccess) { grid = -1; return; }
        if (hipFuncSetAttribute((const void*)fwd_kernel, hipFuncAttributeMaxDynamicSharedMemorySize, LDS_BYTES) != hipSuccess) { fprintf(stderr, "kernel_launch: hipFuncSetAttribute failed\n"); grid = -1; return; }
        if (hipOccupancyMaxActiveBlocksPerMultiprocessor(&per_cu, (const void*)fwd_kernel, 512, LDS_BYTES) != hipSuccess || per_cu < 1) { fprintf(stderr, "kernel_launch: occupancy query says %d\n", per_cu); per_cu = 1; }
        (void)hipGetLastError();
        grid = cus * 1;
        fprintf(stderr, "kernel_launch: grid %d (cus %d, per_cu %d)\n", grid, cus, per_cu);
    }
    if (grid < 0) return;
    Params p{};
    const float** pp = (const float**)&p;
    for (int i = 0; i < 27; ++i) pp[i] = (const float*)d_in[i];
    p.out = (float*)d_out; p.ws = (unsigned char*)d_ws;
#if MK_MULTI
    for (int k = 0; k < N_PHASES; ++k) { p.ph_lo = k; p.ph_hi = k + 1; void* args[] = {&p};
        hipError_t e = hipLaunchCooperativeKernel((const void*)fwd_kernel, dim3(grid), dim3(512), args, LDS_BYTES, stream);
        if (e != hipSuccess) { fprintf(stderr, "kernel_launch: launch %d failed: %s\n", k, hipGetErrorString(e)); break; } }
#else
    for (int pass = 0; pass < MK_PASSES; ++pass) {
    if (hipMemsetAsync((char*)d_ws + WS_BAR, 0, WS_ZERO_BYTES, stream) != hipSuccess) { fprintf(stderr, "kernel_launch: memset failed\n"); return; }
    p.ph_lo = 0; p.ph_hi = N_PHASES; void* args[] = {&p};
    hipError_t e = hipLaunchCooperativeKernel((const void*)fwd_kernel, dim3(grid), dim3(512), args, LDS_BYTES, stream);
    if (e != hipSuccess) fprintf(stderr, "kernel_launch: cooperative launch failed: %s (grid %d)\n", hipGetErrorString(e), grid);
    }
#endif
}
```

```cpp
#include <hip/hip_runtime.h>
#include <hip/hip_cooperative_groups.h>
#include <cstdio>
#include <cstdint>
namespace cg = cooperative_groups;

#define LAS __attribute__((address_space(3)))
typedef unsigned short bf16;
typedef short bf16x8 __attribute__((ext_vector_type(8)));
typedef float f32x4 __attribute__((ext_vector_type(4)));
typedef float f32x2 __attribute__((ext_vector_type(2)));
typedef float f32x16 __attribute__((ext_vector_type(16)));
typedef unsigned u32x4 __attribute__((ext_vector_type(4)));
typedef unsigned u32x2 __attribute__((ext_vector_type(2)));

constexpr int DM = 1024, NB = 8, SEQ = 2048, CTXL = 256, M_TOK = NB * SEQ, M_CTX = NB * CTXL;
constexpr int HYW = 512, HYC = 1536, NIN = 3072, NREST = 1536  , DFF = 2816, NUP = 5632;
constexpr int NH = 4, DK = 64, DV = 128, CH = 128, NCHUNK = 16;
constexpr float EPS = 1e-6f;

constexpr size_t MiB = 1u << 20;
constexpr size_t WS_WINT = 0, WS_WOUTT = 6 * MiB, WS_WUPT = 8 * MiB, WS_WDNT = 19 * MiB;
constexpr size_t WS_MOD = 25 * MiB, WS_BIAS2 = 25 * MiB + 256 * 1024, WS_SUMSQ = 25 * MiB + 512 * 1024, WS_ROPE = 26 * MiB;
constexpr size_t WS_FILT = 27 * MiB, WS_HALO = 35 * MiB;
constexpr size_t WS_YCAT = 46 * MiB, WS_HC = 46 * MiB, WS_YT = 78 * MiB, WS_ZT = 94 * MiB, WS_QKVG = 142 * MiB, WS_UC = 190 * MiB, WS_KV = 193 * MiB;
constexpr size_t WS_SST = 229 * MiB, WS_X1B = 78 * MiB;
constexpr size_t WS_HCP = 50 * MiB;
constexpr size_t WS_BAR_BASE = 25 * MiB + 640 * 1024;
constexpr size_t WS_ROWCTR = WS_BAR_BASE + 32768, WS_CNT4 = WS_BAR_BASE + 36864, WS_CNT5 = WS_BAR_BASE + 40960;
constexpr size_t WS_ZERO_BYTES = 45056;
constexpr size_t WS_H = 222 * MiB, WS_A2 = 222 * MiB, WS_APRE = 110 * MiB, WS_END = 256 * MiB;
constexpr int LDS_BYTES = 147456;

__device__ __forceinline__ unsigned cvt_pk_bf16(float lo, float hi) { unsigned r; asm volatile("v_cvt_pk_bf16_f32 %0, %1, %2" : "=v"(r) : "v"(lo), "v"(hi)); return r; }
__device__ __forceinline__ float bf2f(unsigned h) { return __uint_as_float(h << 16); }
__device__ __forceinline__ float bflo(unsigned w) { return __uint_as_float(w << 16); }
__device__ __forceinline__ float bfhi(unsigned w) { return __uint_as_float(w & 0xffff0000u); }
__device__ __forceinline__ unsigned short f2bf(float f) { return (unsigned short)(cvt_pk_bf16(f, 0.f) & 0xffffu); }
__device__ __forceinline__ float wave_sum(float v) {
#pragma unroll
    for (int o = 1; o < 64; o <<= 1) v += __shfl_xor(v, o);
    return v;
}
__device__ __forceinline__ float silu_f(float v) { return v / (1.0f + __expf(-v)); }
#define LDS_WAIT() asm volatile("s_waitcnt lgkmcnt(0)" ::: "memory")

__device__ __forceinline__ void tile_publish(unsigned* ctr) {
    asm volatile("s_waitcnt vmcnt(0)" ::: "memory"); __syncthreads();
    if (threadIdx.x == 0) { __builtin_amdgcn_fence(__ATOMIC_RELEASE, "agent"); asm volatile("s_waitcnt vmcnt(0)" ::: "memory");
        __hip_atomic_fetch_add(ctr, 1u, __ATOMIC_RELAXED, __HIP_MEMORY_SCOPE_AGENT); }
}
__device__ __forceinline__ void tile_wait(unsigned* c0, unsigned* c1, unsigned* c2, unsigned need) {
    if (threadIdx.x == 0) { unsigned sp = 0;
        for (;;) { bool ok = __hip_atomic_load(c0, __ATOMIC_RELAXED, __HIP_MEMORY_SCOPE_AGENT) >= need;
            if (ok && c1) ok = __hip_atomic_load(c1, __ATOMIC_RELAXED, __HIP_MEMORY_SCOPE_AGENT) >= need;
            if (ok && c2) ok = __hip_atomic_load(c2, __ATOMIC_RELAXED, __HIP_MEMORY_SCOPE_AGENT) >= need;
            if (ok || ++sp > (1u << 22)) break; __builtin_amdgcn_s_sleep(4); }
        __builtin_amdgcn_fence(__ATOMIC_ACQUIRE, "agent"); asm volatile("s_waitcnt vmcnt(0)" ::: "memory"); }
    __syncthreads();
}
namespace pg8 {
constexpr int BM = 256, BK = 64, HALF = 128, HTB = HALF * BK * 2, STAGE_BYTES = 8 * HTB, NXCD = 8, WGM = 8;
__host__ __device__ __forceinline__ int lds_byte(int r, int c) { const int st = (r >> 4) * 2 + (c >> 5), rr = r & 15, cc = c & 31, ob = rr * 64 + cc * 2; return st * 1024 + (ob ^ (((ob >> 9) & 1) << 5)); }
__host__ __device__ __forceinline__ void stage_rc(int b, int& R, int& C) { const int st = b / 1024, sb = b % 1024, swz = sb ^ (((sb >> 9) & 1) << 5); R = (st >> 1) * 16 + swz / 64; C = (st & 1) * 32 + (swz % 64) / 2; }
__host__ __device__ __forceinline__ int perm32(int rho) { const int n = rho >> 4, i = rho & 15; return 8 * (i >> 2) + 4 * n + (i & 3); }

struct Unit { int pm, pn, kind; };
struct Gemm { int K; int lda, ldb; int pairA; };

template <int NM, int NN> __device__ __forceinline__ void order_tile(int L, int& pm, int& pn) {
    constexpr int nwg = NM * NN, q = nwg / NXCD, r = nwg % NXCD;
    const int xcd = L % NXCD, off = L / NXCD;
    const int wgid = (xcd < r ? xcd * (q + 1) : r * (q + 1) + (xcd - r) * q) + off;
    constexpr int nig = WGM * NN; const int gid = wgid / nig, fm = gid * WGM, gsz = (NM - fm) < WGM ? (NM - fm) : WGM;
    pm = fm + ((wgid % nig) % gsz); pn = (wgid % nig) / gsz;
}

template <class Epi, class Sched, bool ALIGN_EPI = true, bool SP2 = true>
__device__ __forceinline__ void gemm_phase(LAS unsigned char* lds, const Gemm g, const Sched& S, const Epi& E) {
    const int tid = threadIdx.x, wid = __builtin_amdgcn_readfirstlane(tid >> 6), lane = tid & 63, wr = wid >> 2, wc = wid & 3, fr = lane & 15, fq = lane >> 4;
    const int K = g.K, nt = K / BK;
    unsigned voffA[2], voffB[2];
#pragma unroll
    for (int i = 0; i < 2; ++i) { int R, C; stage_rc(tid * 16 + i * 8192, R, C); const int Rb = Epi::PERM ? ((R & ~31) + perm32(R & 31)) : R;
        voffA[i] = (unsigned)(R * g.lda + C) * 2u; voffB[i] = (unsigned)(Rb * g.ldb + C) * 2u; }
    const size_t kstep = (size_t)(BK * 2);
    const size_t hstepA = (size_t)HALF * g.lda * 2, hstepB = (size_t)HALF * g.ldb * 2;
    const size_t pairA = (size_t)g.pairA, pairB = 2 * kstep;
    const unsigned ldsw = (unsigned)wid * 1024u;
    const int aoff = lds_byte(wr * 64 + fr, fq * 8), boff = lds_byte(wc * 32 + fr, fq * 8);
#define PG8_SA(b, h) (((b) * 2 + (h)) * HTB)
#define PG8_SB(b, h) ((4 + (b) * 2 + (h)) * HTB)
#define PG8_STAGE(bufoff, gbase, voff) do { _Pragma("unroll") for (int _i = 0; _i < 2; ++_i) \
        __builtin_amdgcn_global_load_lds((const unsigned*)((const char*)(gbase) + (voff)[_i]), (LAS unsigned*)(lds + (bufoff) + ldsw + _i * 8192), 16, 0, 0); } while (0)
#define PG8_LDA(dst, b, h) do { _Pragma("unroll") for (int m = 0; m < 4; ++m) _Pragma("unroll") for (int k = 0; k < 2; ++k) dst[m][k] = *(const LAS bf16x8*)(lds + PG8_SA(b, h) + aoff + m * 2048 + k * 1024); } while (0)
#define PG8_LDB(dst, b, h) do { _Pragma("unroll") for (int n = 0; n < 2; ++n) _Pragma("unroll") for (int k = 0; k < 2; ++k) dst[n][k] = *(const LAS bf16x8*)(lds + PG8_SB(b, h) + boff + n * 2048 + k * 1024); } while (0)
#define PG8_MMA(ai, bj, At, Bt) do { __builtin_amdgcn_s_setprio(1); _Pragma("unroll") for (int m = 0; m < 4; ++m) _Pragma("unroll") for (int n = 0; n < 2; ++n) _Pragma("unroll") for (int k = 0; k < 2; ++k) \
        acc[ai][bj][m][n] = __builtin_amdgcn_mfma_f32_16x16x32_bf16(Bt[n][k], At[m][k], acc[ai][bj][m][n], 0, 0, 0); __builtin_amdgcn_s_setprio(0); } while (0)
#define PG8_WAIT_V(n) asm volatile("s_waitcnt vmcnt(" #n ")" ::: "memory")
#define PG8_WAIT_L(n) asm volatile("s_waitcnt lgkmcnt(" #n ")" ::: "memory")
#define PG8_BAR __builtin_amdgcn_s_barrier()
#define PG8_SCHED __builtin_amdgcn_sched_barrier(0)
    Unit cur, nxt; int ui = 0;
    if (!S.next(0, cur)) return;
    f32x4 acc[2][2][4][2];
#pragma unroll
    for (int a = 0; a < 2; ++a)
#pragma unroll
        for (int b = 0; b < 2; ++b)
#pragma unroll
            for (int m = 0; m < 4; ++m)
#pragma unroll
                for (int n = 0; n < 2; ++n) acc[a][b][m][n] = (f32x4){0.f, 0.f, 0.f, 0.f};
    bf16x8 At[4][2], B0[2][2], B1[2][2];
    const char* cA; const char* cB; S.ptrs(cur, cA, cB);
    if constexpr (SP2) {
        PG8_STAGE(PG8_SB(0, 0), cB, voffB); PG8_STAGE(PG8_SB(0, 1), cB + hstepB, voffB); PG8_STAGE(PG8_SA(0, 0), cA, voffA); PG8_STAGE(PG8_SA(0, 1), cA + hstepA, voffA);
        if (wr == 1) PG8_BAR;
        PG8_WAIT_V(2); PG8_BAR;
        PG8_STAGE(PG8_SB(1, 0), cB + kstep, voffB); PG8_STAGE(PG8_SA(1, 0), cA + kstep, voffA); PG8_STAGE(PG8_SB(1, 1), cB + hstepB + kstep, voffB);
        PG8_WAIT_V(6); PG8_BAR;
    } else {
        PG8_STAGE(PG8_SB(0, 0), cB, voffB); PG8_STAGE(PG8_SA(0, 0), cA, voffA); PG8_STAGE(PG8_SB(0, 1), cB + hstepB, voffB); PG8_STAGE(PG8_SA(0, 1), cA + hstepA, voffA);
        if (wr == 1) PG8_BAR;
        PG8_WAIT_V(4); PG8_BAR;
        PG8_STAGE(PG8_SB(1, 0), cB + kstep, voffB); PG8_STAGE(PG8_SA(1, 0), cA + kstep, voffA); PG8_STAGE(PG8_SB(1, 1), cB + hstepB + kstep, voffB);
        PG8_WAIT_V(6); PG8_BAR;
    }
    for (;;) {
        const bool has_next = S.next(ui + 1, nxt);
        const char* nA = cA; const char* nB = cB; if (has_next) S.ptrs(nxt, nA, nB);
        for (int t = 0; t < nt; t += 2) {
            const bool last = (t == nt - 2);
            const char* a0 = cA + (size_t)(t >> 1) * pairA;
            const char* a1 = a0 + kstep;
            const char* a2 = last ? nA : a0 + pairA; const char* b2 = last ? nB : cB + (size_t)(t >> 1) * pairB + pairB;
            const char* a3 = a2 + kstep; const char* b3 = b2 + kstep;
            if constexpr (SP2) {
            PG8_LDB(B0, 0, 0); PG8_LDB(B1, 0, 1); PG8_SCHED; PG8_LDA(At, 0, 0); PG8_STAGE(PG8_SA(1, 1), a1 + hstepA, voffA);
            PG8_WAIT_V(8); PG8_WAIT_L(0); PG8_BAR; PG8_MMA(0, 0, At, B0); PG8_MMA(0, 1, At, B1); PG8_BAR; PG8_SCHED;
            PG8_LDA(At, 0, 1); PG8_STAGE(PG8_SB(0, 0), b2, voffB); PG8_STAGE(PG8_SB(0, 1), b2 + hstepB, voffB); PG8_STAGE(PG8_SA(0, 0), a2, voffA);
            PG8_WAIT_V(8); PG8_WAIT_L(0); PG8_BAR; PG8_MMA(1, 0, At, B0); PG8_MMA(1, 1, At, B1); PG8_BAR; PG8_SCHED;
            PG8_LDB(B0, 1, 0); PG8_LDB(B1, 1, 1); PG8_SCHED; PG8_LDA(At, 1, 0); PG8_STAGE(PG8_SA(0, 1), a2 + hstepA, voffA);
            PG8_WAIT_V(8); PG8_WAIT_L(0); PG8_BAR; PG8_MMA(0, 0, At, B0); PG8_MMA(0, 1, At, B1); PG8_BAR; PG8_SCHED;
            PG8_LDA(At, 1, 1); PG8_STAGE(PG8_SB(1, 0), b3, voffB); PG8_STAGE(PG8_SB(1, 1), b3 + hstepB, voffB); PG8_STAGE(PG8_SA(1, 0), a3, voffA);
            PG8_WAIT_V(8); PG8_WAIT_L(0); PG8_BAR; PG8_MMA(1, 0, At, B0); PG8_MMA(1, 1, At, B1); PG8_BAR; PG8_SCHED;
            } else {
            PG8_LDB(B0, 0, 0); PG8_SCHED; PG8_LDA(At, 0, 0); PG8_STAGE(PG8_SA(1, 1), a1 + hstepA, voffA);
            PG8_WAIT_L(8); PG8_BAR; PG8_WAIT_L(0); PG8_MMA(0, 0, At, B0); PG8_BAR; PG8_SCHED;
            PG8_LDB(B1, 0, 1); PG8_STAGE(PG8_SB(0, 0), b2, voffB);
            PG8_BAR; PG8_WAIT_L(0); PG8_MMA(0, 1, At, B1); PG8_BAR;
            PG8_LDA(At, 0, 1); PG8_STAGE(PG8_SA(0, 0), a2, voffA);
            PG8_BAR; PG8_WAIT_L(0); PG8_MMA(1, 0, At, B0); PG8_BAR; PG8_SCHED;
            PG8_STAGE(PG8_SB(0, 1), b2 + hstepB, voffB);
            PG8_WAIT_V(6); PG8_BAR; PG8_MMA(1, 1, At, B1); PG8_BAR;
            PG8_LDB(B0, 1, 0); PG8_SCHED; PG8_LDA(At, 1, 0); PG8_STAGE(PG8_SA(0, 1), a2 + hstepA, voffA);
            PG8_WAIT_L(8); PG8_BAR; PG8_WAIT_L(0); PG8_MMA(0, 0, At, B0); PG8_BAR; PG8_SCHED;
            PG8_LDB(B1, 1, 1); PG8_STAGE(PG8_SB(1, 0), b3, voffB);
            PG8_BAR; PG8_WAIT_L(0); PG8_MMA(0, 1, At, B1); PG8_BAR;
            PG8_LDA(At, 1, 1); PG8_STAGE(PG8_SA(1, 0), a3, voffA);
            PG8_BAR; PG8_WAIT_L(0); PG8_MMA(1, 0, At, B0); PG8_BAR; PG8_SCHED;
            PG8_STAGE(PG8_SB(1, 1), b3 + hstepB, voffB);
            PG8_WAIT_V(6); PG8_BAR; PG8_MMA(1, 1, At, B1); PG8_BAR;
            }
        }
        if constexpr (ALIGN_EPI) { if (wr == 0) PG8_BAR; }
        E(acc, cur, wr, wc, fr, fq, lds);
        if (!has_next) break;
#pragma unroll
        for (int a = 0; a < 2; ++a)
#pragma unroll
            for (int b = 0; b < 2; ++b)
#pragma unroll
                for (int m = 0; m < 4; ++m)
#pragma unroll
                    for (int n = 0; n < 2; ++n) acc[a][b][m][n] = (f32x4){0.f, 0.f, 0.f, 0.f};
        cur = nxt; cA = nA; cB = nB; ++ui;
        if constexpr (ALIGN_EPI) { if (wr == 1) PG8_BAR; }
    }
    PG8_WAIT_V(0);
    if constexpr (!ALIGN_EPI) { if (wr == 0) PG8_BAR; }
    PG8_BAR;
#undef PG8_SA
#undef PG8_SB
#undef PG8_STAGE
#undef PG8_LDA
#undef PG8_LDB
#undef PG8_MMA
#undef PG8_WAIT_V
#undef PG8_WAIT_L
#undef PG8_BAR
#undef PG8_SCHED
}
}
struct Params {
    const float *x, *c, *ctx, *c_ctx, *w_mod, *b_mod, *norm1, *w_in, *hy_conv_w, *hy_conv_b, *hy_w1, *hy_b1, *hy_f1, *hy_w2, *hy_b2, *hy_f2, *hy_w3, *hy_bias,
        *ret_logit_f, *ret_logit_b, *w_out, *norm2, *ffn_w_up, *ffn_conv_w, *ffn_conv_b, *ffn_w_down, *norm_f;
    float* out; unsigned char* ws; int ph_lo, ph_hi;
};
#define WSP(T, off) ((T*)(p.ws + (off)))

__device__ __forceinline__ void transpose_item(const float* W, int K, int N, bf16* WT, int drow0, int k0, int n0, LAS float* scr, int lane) {
    float tv[32];
#pragma unroll
    for (int i = 0; i < 32; ++i) { const int kk = 2 * i + (lane >> 5); tv[i] = __builtin_nontemporal_load(W + (size_t)(k0 + kk) * N + n0 + (lane & 31)); }
#pragma unroll
    for (int i = 0; i < 32; ++i) { const int kk = 2 * i + (lane >> 5); scr[kk * 33 + (lane & 31)] = tv[i]; }
    LDS_WAIT(); asm volatile("" ::: "memory");
    const int c = lane & 7;
#pragma unroll
    for (int j = 0; j < 4; ++j) { const int n = (lane >> 3) + 8 * j; const LAS float* s = scr + (8 * c) * 33 + n;
        u32x4 o; o.x = cvt_pk_bf16(s[0 * 33], s[1 * 33]); o.y = cvt_pk_bf16(s[2 * 33], s[3 * 33]); o.z = cvt_pk_bf16(s[4 * 33], s[5 * 33]); o.w = cvt_pk_bf16(s[6 * 33], s[7 * 33]);
        *(u32x4*)(WT + (size_t)(drow0 + n) * K + k0 + 8 * c) = o; }
    LDS_WAIT(); asm volatile("" ::: "memory");
}

__device__ __forceinline__ void transposes_late(const Params& p, LAS unsigned char* lds, int slot, int nslots) {
    const int lane = threadIdx.x & 63, wave = threadIdx.x >> 6;
    LAS float* scr = (LAS float*)(lds + wave * 16384);
    constexpr int I_OUT = 16 * 32, I_UP = 16 * 176, I_DN = 44 * 32;
    for (int it = slot; it < I_OUT + I_UP + I_DN; it += nslots) {
        int r = it;
        if (r < I_OUT) { const int kb = r / 32, nb = r % 32; transpose_item(p.w_out, DM, DM, WSP(bf16, WS_WOUTT), 32 * nb, 64 * kb, 32 * nb, scr, lane); continue; } r -= I_OUT;
        if (r < I_UP) { const int kb = r / 176, nb = r % 176; const int n0 = 32 * nb;
            const int drow = (n0 < DFF) ? (256 * (n0 / 128) + (n0 % 128)) : (256 * ((n0 - DFF) / 128) + 128 + ((n0 - DFF) % 128));
            transpose_item(p.ffn_w_up, DM, NUP, WSP(bf16, WS_WUPT), drow, 64 * kb, n0, scr, lane); continue; } r -= I_UP;
        { const int kb = r / 32, nb = r % 32; transpose_item(p.ffn_w_down, DFF, DM, WSP(bf16, WS_WDNT), 32 * nb, 64 * kb, 32 * nb, scr, lane); }
    }
}
__device__ __forceinline__ void bias2_rows(const Params& p) {
    const int lane = threadIdx.x & 63, gw = blockIdx.x * 8 + (threadIdx.x >> 6), NGW = gridDim.x * 8;
    const float* mod = WSP(float, WS_MOD); const bf16* wup = WSP(bf16, WS_WUPT); float* bias2 = WSP(float, WS_BIAS2);
    for (int r = gw; r < NUP; r += NGW) {
        float wv[16];
#pragma unroll
        for (int jj = 0; jj < 2; ++jj) { const u32x4 w = *(const u32x4*)(wup + (size_t)r * DM + 8 * lane + 512 * jj);
            wv[8 * jj + 0] = bflo(w.x); wv[8 * jj + 1] = bfhi(w.x); wv[8 * jj + 2] = bflo(w.y); wv[8 * jj + 3] = bfhi(w.y); wv[8 * jj + 4] = bflo(w.z); wv[8 * jj + 5] = bfhi(w.z); wv[8 * jj + 6] = bflo(w.w); wv[8 * jj + 7] = bfhi(w.w); }
        for (int b = 0; b < 8; ++b) { float s = 0.f;
#pragma unroll
            for (int jj = 0; jj < 2; ++jj) { const float* sh2 = mod + b * 6144 + 3072 + 8 * lane + 512 * jj; const f32x4 s0 = *(const f32x4*)sh2, s1 = *(const f32x4*)(sh2 + 4);
                s += wv[8 * jj + 0] * s0.x + wv[8 * jj + 1] * s0.y + wv[8 * jj + 2] * s0.z + wv[8 * jj + 3] * s0.w + wv[8 * jj + 4] * s1.x + wv[8 * jj + 5] * s1.y + wv[8 * jj + 6] * s1.z + wv[8 * jj + 7] * s1.w; }
            s = wave_sum(s); if (lane == 0) bias2[b * NUP + r] = s; }
    }
}

__device__ __forceinline__ void phase0a(const Params& p, LAS unsigned char* lds) {
    const int tid = threadIdx.x, lane = tid & 63, wave = tid >> 6, G = gridDim.x, bx = blockIdx.x;
    if (bx >= 192) {
        LAS float* scr = (LAS float*)(lds + wave * 16384);
        for (int it = (bx - 192) * 8 + wave; it < 16 * 96; it += 512) { const int kb = it / 96, nb = it % 96;
            transpose_item(p.w_in, DM, NIN, WSP(bf16, WS_WINT), 32 * nb, 64 * kb, 32 * nb, scr, lane); }
    }
    __syncthreads();
    if (bx < 192) {
        LAS float* sl = (LAS float*)lds;
        LAS float* red = (LAS float*)(lds + 9 * 1024 * 4);
        for (int i = tid; i < 9 * 1024; i += 512) { const int r = i >> 10, k = i & 1023; const float v = (r < 8) ? p.c[r * 1024 + k] : p.c_ctx[k]; sl[i] = silu_f(v); }
        __syncthreads();
        const int col = bx * 32 + (lane & 31), kpar = lane >> 5;
        float acc[9];
#pragma unroll
        for (int r = 0; r < 9; ++r) acc[r] = 0.f;
        for (int k16 = 0; k16 < 64; k16 += 32) { float wv[32];
#pragma unroll
            for (int kk = 0; kk < 32; ++kk) wv[kk] = __builtin_nontemporal_load(p.w_mod + (size_t)(wave * 128 + 2 * (k16 + kk) + kpar) * 6144 + col);
#pragma unroll
            for (int kk = 0; kk < 32; ++kk) { const int k = wave * 128 + 2 * (k16 + kk) + kpar;
#pragma unroll
                for (int r = 0; r < 9; ++r) acc[r] += sl[r * 1024 + k] * wv[kk]; } }
#pragma unroll
        for (int r = 0; r < 9; ++r) { acc[r] += __shfl_xor(acc[r], 32); if (lane < 32) red[(wave * 9 + r) * 32 + lane] = acc[r]; }
        __syncthreads();
        if (tid < 9 * 32) { const int r = tid >> 5, cl = tid & 31; float s = p.b_mod[bx * 32 + cl];
#pragma unroll
            for (int w = 0; w < 8; ++w) s += red[(w * 9 + r) * 32 + cl];
            WSP(float, WS_MOD)[r * 6144 + bx * 32 + cl] = s; }
        tile_publish(WSP(unsigned, WS_CNT4));
    }
    __syncthreads();
    for (int it = bx; it < 256; it += G) {
        LAS float* z = (LAS float*)lds;
        LAS float* h1 = z + 8 * 33;
        LAS float* h2 = h1 + 8 * 64;
        const int p0 = 8 * it;
        if (tid < 8 * 33) { const int pp = tid / 33, f = tid % 33; const float pos = (float)(p0 + pp); float v;
            if (f == 0) v = pos / 2047.0f;
            else { const int bi = (f - 1) & 15; const float band = 1e-4f + (float)bi * ((15.0f - 1e-4f) / 15.0f); const float ang = 6.283185307179586f * pos * band / 2048.0f; v = (f <= 16) ? cosf(ang) : -sinf(ang); }
            z[pp * 33 + f] = v; }
        __syncthreads();
        { const int pp = tid >> 6, j = tid & 63; float s = p.hy_b1[j];
#pragma unroll
          for (int f = 0; f < 33; ++f) s += z[pp * 33 + f] * p.hy_w1[f * 64 + j];
          h1[pp * 64 + j] = sinf(p.hy_f1[j] * s); }
        __syncthreads();
        { const int pp = tid >> 6, j = tid & 63; float s = p.hy_b2[j];
#pragma unroll 8
          for (int i = 0; i < 64; ++i) s += h1[pp * 64 + i] * p.hy_w2[i * 64 + j];
          h2[pp * 64 + j] = sinf(p.hy_f2[j] * s); }
        __syncthreads();
        bf16* kern = WSP(bf16, WS_FILT);
        float aq[4][8];
#pragma unroll
        for (int q = 0; q < 4; ++q)
#pragma unroll
            for (int pp = 0; pp < 8; ++pp) aq[q][pp] = 0.f;
        for (int j0 = 0; j0 < 64; j0 += 16) { float wv[4][16];
#pragma unroll
            for (int q = 0; q < 4; ++q)
#pragma unroll
                for (int jj = 0; jj < 16; ++jj) wv[q][jj] = p.hy_w3[(j0 + jj) * 2048 + tid + 512 * q];
#pragma unroll
            for (int jj = 0; jj < 16; ++jj)
#pragma unroll
                for (int pp = 0; pp < 8; ++pp) { const float hv = h2[pp * 64 + j0 + jj];
#pragma unroll
                    for (int q = 0; q < 4; ++q) aq[q][pp] += hv * wv[q][jj]; } }
#pragma unroll
        for (int q = 0; q < 4; ++q) {
            const int col = tid + 512 * q, dir = col >> 10, o = (col >> 9) & 1, ch = col & 511;
            float a[8];
#pragma unroll
            for (int pp = 0; pp < 8; ++pp) a[pp] = aq[q][pp];
            const float mind = -4.605170185988091f / 1.5f, maxd = -4.605170185988091f / 0.3f;
            const float ad = fabsf(mind + (float)ch * ((maxd - mind) / 511.0f));
#pragma unroll
            for (int pp = 0; pp < 8; ++pp) a[pp] *= __expf(-((float)(p0 + pp) / 2047.0f) * ad);
            bf16* kr = kern + ((size_t)(o * 512 + ch)) * 4096;
            if (dir == 0) { u32x4 w; w.x = cvt_pk_bf16(a[0], a[1]); w.y = cvt_pk_bf16(a[2], a[3]); w.z = cvt_pk_bf16(a[4], a[5]); w.w = cvt_pk_bf16(a[6], a[7]); *(u32x4*)(kr + 2048 + p0) = w; }
            else {
#pragma unroll
                for (int pp = 0; pp < 8; ++pp) { const int pos = p0 + pp; if (pos == 0) kr[0] = 0; else kr[2048 - pos] = f2bf(a[pp]); } }
        }
        __syncthreads();
    }
    {
        const int gt = bx * 512 + tid, NT = G * 512;
        f32x2* rope = WSP(f32x2, WS_ROPE);
        for (int i = gt; i < 2048 * 32; i += NT) { const int t = i >> 5, jf = i & 31; const float pos = (jf < 16) ? (float)(t >> 6) : (float)(t & 63);
            const float inv = exp2f(-(float)(jf & 15) * (13.287712379549449f / 16.0f)); const float ang = pos * inv; rope[i] = (f32x2){cosf(ang), sinf(ang)}; }
        float* ssq = WSP(float, WS_SUMSQ);
        for (int i = gt; i < 2 * M_TOK; i += NT) ssq[i] = 0.f;
    }
}

__device__ __forceinline__ void norm_rows4(const float* src0, bf16* dst0, const float* norm1, const float* modb, int lane) {
    f32x4 v[4][4]; float ss[4];
#pragma unroll
    for (int r = 0; r < 4; ++r)
#pragma unroll
        for (int j = 0; j < 4; ++j) v[r][j] = __builtin_nontemporal_load((const f32x4*)(src0 + (size_t)r * DM) + lane + 64 * j);
#pragma unroll
    for (int r = 0; r < 4; ++r) { float s = 0.f;
#pragma unroll
        for (int j = 0; j < 4; ++j) s += (v[r][j].x * v[r][j].x + v[r][j].y * v[r][j].y) + (v[r][j].z * v[r][j].z + v[r][j].w * v[r][j].w);
        ss[r] = s; }
#pragma unroll
    for (int o = 1; o < 64; o <<= 1) {
#pragma unroll
        for (int r = 0; r < 4; ++r) ss[r] += __shfl_xor(ss[r], o); }
#pragma unroll
    for (int j = 0; j < 4; ++j) { const int c4 = lane + 64 * j;
        const f32x4 g = ((const f32x4*)norm1)[c4], sh = ((const f32x4*)modb)[c4], sc = ((const f32x4*)(modb + 1024))[c4];
        const f32x4 gg = g * (sc + 1.0f);
#pragma unroll
        for (int r = 0; r < 4; ++r) { const float rstd = rsqrtf(ss[r] * (1.0f / DM) + EPS); const f32x4 o = v[r][j] * rstd * gg + sh;
            u32x2 w; w.x = cvt_pk_bf16(o.x, o.y); w.y = cvt_pk_bf16(o.z, o.w); ((u32x2*)(dst0 + (size_t)r * DM))[c4] = w; } }
}
struct SchedOne {
    const char* A; const char* B; int pm, pn, kind;
    __device__ __forceinline__ bool next(int i, pg8::Unit& u) const { if (i != 0) return false; u.pm = pm; u.pn = pn; u.kind = kind; return true; }
    __device__ __forceinline__ void ptrs(const pg8::Unit&, const char*& a, const char*& b) const { a = A; b = B; }
};
struct EpiP1;
template <class E> __device__ __forceinline__ void phase0b(const Params& p, LAS unsigned char* lds, const E& epi) {
    const int tid = threadIdx.x, lane = tid & 63, wave = tid >> 6, G = gridDim.x, bx = blockIdx.x;
    const int gw = bx * 8 + wave, NGW = G * 8;
    const float* mod = WSP(float, WS_MOD);
    tile_wait(WSP(unsigned, WS_CNT4), nullptr, nullptr, 192u);
    for (int i = 0; i < 3; ++i) { const int ch4 = i < 2 ? gw + i * NGW : ((gw & 3) == 0 ? 2 * NGW + (gw >> 2) : (M_TOK + M_CTX)); if (ch4 >= (M_TOK + M_CTX) / 4) continue; const int base = ch4 * 4;
        if (base < M_TOK) norm_rows4(p.x + (size_t)base * DM, WSP(bf16, WS_H) + (size_t)base * DM, p.norm1, mod + (base >> 11) * 6144, lane);
        else norm_rows4(p.ctx + (size_t)(base - M_TOK) * DM, WSP(bf16, WS_HC) + (size_t)(base - M_TOK) * DM, p.norm1, mod + 8 * 6144, lane); }
}

struct SchedP1 {
    const char* wint; const char* h; const char* hc; int G, c;
    __device__ __forceinline__ bool next(int i, pg8::Unit& u) const {
        const int L = i * G + c;
        if (L < 384) { u.kind = 0; pg8::order_tile<6, 64>(L, u.pm, u.pn); return true; }
        if (L < 768) { u.kind = 1; pg8::order_tile<64, 6>(L - 384, u.pm, u.pn); return true; }
        return false;
    }
    __device__ __forceinline__ void ptrs(const pg8::Unit& u, const char*& A, const char*& B) const {
        constexpr size_t TS = (size_t)256 * DM * 2;
        if (u.kind == 0) { A = wint + (size_t)u.pm * TS; B = h + (size_t)u.pn * TS; }
        else if (u.kind == 1) { A = h + (size_t)u.pm * TS; B = wint + (size_t)(6 + u.pn) * TS; }
        else { A = hc + (size_t)u.pm * TS; B = wint + (size_t)(7 + u.pn) * TS; }
    }
};
struct EpiP1 {
    static constexpr bool PERM = true;
    bf16* zT; bf16* qkvg; bf16* uc;
    __device__ __forceinline__ void operator()(f32x4 (&acc)[2][2][4][2], const pg8::Unit& u, int wr, int wc, int fr, int fq, LAS unsigned char* lds) const {
        bf16* O; int ldc; if (u.kind == 0) { O = zT; ldc = M_TOK; } else if (u.kind == 1) { O = qkvg; ldc = NREST; } else { O = uc; ldc = 768; }
        const int row0 = u.pm * 256 + wr * 64 + fr, col0 = u.pn * 256 + wc * 32 + 8 * fq;
#pragma unroll
        for (int ai = 0; ai < 2; ++ai)
#pragma unroll
            for (int m = 0; m < 4; ++m) { bf16* rowp = O + (size_t)(row0 + ai * 128 + m * 16) * ldc + col0;
#pragma unroll
                for (int bj = 0; bj < 2; ++bj) { const f32x4 v0 = acc[ai][bj][m][0], v1 = acc[ai][bj][m][1];
                    u32x4 w; w.x = cvt_pk_bf16(v0[0], v0[1]); w.y = cvt_pk_bf16(v0[2], v0[3]); w.z = cvt_pk_bf16(v1[0], v1[1]); w.w = cvt_pk_bf16(v1[2], v1[3]);
                    *(u32x4*)(rowp + bj * 128) = w; } }
    }
};
template <int NM, int NN> struct SchedPlain {
    const char* A; const char* B; size_t tsA, tsB; int G, c;
    __device__ __forceinline__ bool next(int i, pg8::Unit& u) const { const int L = i * G + c; if (L >= NM * NN) return false; u.kind = 2; pg8::order_tile<NM, NN>(L, u.pm, u.pn); return true; }
    __device__ __forceinline__ void ptrs(const pg8::Unit& u, const char*& a, const char*& b) const { a = A + (size_t)u.pm * tsA; b = B + (size_t)u.pn * tsB; }
};
struct EpiP4 {
    static constexpr bool PERM = false;
    const float* x; bf16* x1b; bf16* a2; const float* mod; const float* norm2; float* ssq;
    __device__ __forceinline__ void operator()(f32x4 (&acc)[2][2][4][2], const pg8::Unit& u, int wr, int wc, int fr, int fq, LAS unsigned char* lds) const {
        const int row0 = u.pm * 256 + wr * 64 + fr, b = u.pm >> 3, col0 = u.pn * 256 + wc * 32 + 4 * fq;
        f32x4 g1[2][2], gn[2][2];
#pragma unroll
        for (int bj = 0; bj < 2; ++bj)
#pragma unroll
            for (int n = 0; n < 2; ++n) { const int c = col0 + bj * 128 + n * 16; g1[bj][n] = *(const f32x4*)(mod + b * 6144 + 2048 + c);
                gn[bj][n] = *(const f32x4*)(norm2 + c) * (*(const f32x4*)(mod + b * 6144 + 4096 + c) + 1.0f); }
#pragma unroll
        for (int ai = 0; ai < 2; ++ai) {
            f32x4 xa[4][2][2];
#pragma unroll
            for (int m = 0; m < 4; ++m)
#pragma unroll
                for (int bj = 0; bj < 2; ++bj)
#pragma unroll
                    for (int n = 0; n < 2; ++n) xa[m][bj][n] = *(const f32x4*)(x + (size_t)(row0 + ai * 128 + m * 16) * DM + col0 + bj * 128 + n * 16);
            asm volatile("" ::: "memory");
#pragma unroll
            for (int m = 0; m < 4; ++m) { const int r = row0 + ai * 128 + m * 16; float ss = 0.f;
#pragma unroll
                for (int bj = 0; bj < 2; ++bj)
#pragma unroll
                    for (int n = 0; n < 2; ++n) { const size_t off = (size_t)r * DM + col0 + bj * 128 + n * 16;
                        const f32x4 v = xa[m][bj][n] + g1[bj][n] * acc[ai][bj][m][n];
                        { u32x2 wx; wx.x = cvt_pk_bf16(v.x, v.y); wx.y = cvt_pk_bf16(v.z, v.w); *(u32x2*)(x1b + off) = wx; }
                        ss += (v.x * v.x + v.y * v.y) + (v.z * v.z + v.w * v.w);
                        const f32x4 a = v * gn[bj][n]; u32x2 w; w.x = cvt_pk_bf16(a.x, a.y); w.y = cvt_pk_bf16(a.z, a.w); *(u32x2*)(a2 + off) = w; }
                ss += __shfl_xor(ss, 16); ss += __shfl_xor(ss, 32);
                if (fq == 0) atomicAdd(ssq + r, ss); }
        }
    }
};
#ifndef MK_DPP
#define MK_DPP 1
#endif
__device__ __forceinline__ float rot_prev(float v, int lane) {
#if MK_DPP
    return __int_as_float(__builtin_amdgcn_update_dpp(0, __float_as_int(v), 0x121, 0xF, 0xF, false));
#else
    return __shfl(v, (lane & 48) | ((lane + 15) & 15));
#endif
}
__device__ __forceinline__ float rot_next(float v, int lane) {
#if MK_DPP
    return __int_as_float(__builtin_amdgcn_update_dpp(0, __float_as_int(v), 0x12F, 0xF, 0xF, false));
#else
    return __shfl(v, (lane & 48) | ((lane + 1) & 15));
#endif
}
constexpr int LDS_X = 131072;
struct EpiP5 {
    static constexpr bool PERM = true;
    bf16* act; bf16* halo4; const float* bias2; const float* ssq; const float* cw; const float* cb;
    __device__ __forceinline__ void operator()(f32x4 (&acc)[2][2][4][2], const pg8::Unit& u, int wr, int wc, int fr, int fq, LAS unsigned char* lds) const {
        const int lane = threadIdx.x & 63;
        const int row0 = u.pm * 256 + wr * 64 + fr, b = u.pm >> 3, cp0 = u.pn * 256 + wc * 32 + 8 * fq;
        LAS f32x4* X = (LAS f32x4*)(lds + LDS_X);
#define XIDX(ai_, wr_, wh_, bj_, n_) ((((((ai_) * 2 + (wr_)) * 2 + (wh_)) * 2 + (bj_)) * 4 + wc) * 8 + fq * 2 + (n_))
        {
            f32x4 bv[2][2];
#pragma unroll
            for (int bj = 0; bj < 2; ++bj)
#pragma unroll
                for (int n = 0; n < 2; ++n) bv[bj][n] = *(const f32x4*)(bias2 + b * NUP + cp0 + bj * 128 + 4 * n);
#pragma unroll
            for (int ai = 0; ai < 2; ++ai)
#pragma unroll
                for (int m = 0; m < 4; ++m) { const float rs = rsqrtf(ssq[row0 + ai * 128 + m * 16] * (1.0f / DM) + EPS);
#pragma unroll
                    for (int bj = 0; bj < 2; ++bj)
#pragma unroll
                        for (int n = 0; n < 2; ++n) acc[ai][bj][m][n] = acc[ai][bj][m][n] * rs + bv[bj][n]; }
        }
#pragma unroll
        for (int ai = 0; ai < 2; ++ai) {
            if (fr == 0) {
#pragma unroll
                for (int bj = 0; bj < 2; ++bj)
#pragma unroll
                    for (int n = 0; n < 2; ++n) X[XIDX(ai, wr, 0, bj, n)] = acc[ai][bj][0][n]; }
            if (fr == 15) {
#pragma unroll
                for (int bj = 0; bj < 2; ++bj)
#pragma unroll
                    for (int n = 0; n < 2; ++n) X[XIDX(ai, wr, 1, bj, n)] = acc[ai][bj][3][n]; }
        }
        if (wr == 0 && fr < 2) {
#pragma unroll
            for (int bj = 0; bj < 2; ++bj) { const f32x4 v0 = acc[0][bj][0][0], v1 = acc[0][bj][0][1];
                u32x4 w; w.x = cvt_pk_bf16(v0[0], v0[1]); w.y = cvt_pk_bf16(v0[2], v0[3]); w.z = cvt_pk_bf16(v1[0], v1[1]); w.w = cvt_pk_bf16(v1[2], v1[3]);
                *(u32x4*)(halo4 + ((size_t)u.pm * 4 + fr) * NUP + cp0 + bj * 128) = w; } }
        if (wr == 1 && fr >= 14) {
#pragma unroll
            for (int bj = 0; bj < 2; ++bj) { const f32x4 v0 = acc[1][bj][3][0], v1 = acc[1][bj][3][1];
                u32x4 w; w.x = cvt_pk_bf16(v0[0], v0[1]); w.y = cvt_pk_bf16(v0[2], v0[3]); w.z = cvt_pk_bf16(v1[0], v1[1]); w.w = cvt_pk_bf16(v1[2], v1[3]);
                *(u32x4*)(halo4 + ((size_t)u.pm * 4 + 2 + (fr - 14)) * NUP + cp0 + bj * 128) = w; } }
        LAS f32x4* WL = (LAS f32x4*)(lds + LDS_X + 8192);
        { const int t = threadIdx.x; if (t < 256) { const int k = t >> 6, bj = (t >> 5) & 1, c4 = t & 31;
            WL[(k * 2 + bj) * 32 + c4] = *(const f32x4*)((k < 3 ? cw + k * NUP : cb) + bj * DFF + u.pn * 128 + 4 * c4); } }
        asm volatile("s_waitcnt vmcnt(0) lgkmcnt(0)" ::: "memory"); __builtin_amdgcn_s_barrier(); asm volatile("" ::: "memory");
        const bool f0 = (fr == 0), f15 = (fr == 15);
        const f32x4 zero4 = (f32x4){0.f, 0.f, 0.f, 0.f};
#pragma unroll
        for (int n = 0; n < 2; ++n) {
            const int ov = u.pn * 128 + wc * 32 + 8 * fq + 4 * n, wo = (wc * 32 + 8 * fq + 4 * n) >> 2;
#pragma unroll
            for (int ai = 0; ai < 2; ++ai) {
#pragma unroll
                for (int m = 0; m < 4; ++m) {
                    f32x4 res[2];
#pragma unroll
                    for (int bj = 0; bj < 2; ++bj) {
                        const f32x4 w0 = WL[(0 * 2 + bj) * 32 + wo], w1 = WL[(1 * 2 + bj) * 32 + wo], w2 = WL[(2 * 2 + bj) * 32 + wo], bb = WL[(3 * 2 + bj) * 32 + wo];
                        const f32x4 c_ = acc[ai][bj][m][n];
                        const f32x4 up = (m > 0) ? acc[ai][bj][m - 1][n] : c_;
                        const f32x4 dn = (m < 3) ? acc[ai][bj][m + 1][n] : c_;
                        f32x4 pv, nv;
#pragma unroll
                        for (int e = 0; e < 4; ++e) { pv[e] = rot_prev(f15 ? up[e] : c_[e], lane); nv[e] = rot_next(f0 ? dn[e] : c_[e], lane); }
                        if (m == 0) { f32x4 ep;
                            if (wr == 1) ep = X[XIDX(ai, 0, 1, bj, n)]; else if (ai == 1) ep = X[XIDX(0, 1, 1, bj, n)]; else ep = zero4;
                            pv = f0 ? ep : pv; }
                        if (m == 3) { f32x4 en;
                            if (wr == 0) en = X[XIDX(ai, 1, 0, bj, n)]; else if (ai == 0) en = X[XIDX(1, 0, 0, bj, n)]; else en = zero4;
                            nv = f15 ? en : nv; }
                        res[bj] = w0 * pv + w1 * c_ + w2 * nv + bb;
                    }
                    u32x2 o2; o2.x = cvt_pk_bf16(silu_f(res[1][0]) * res[0][0], silu_f(res[1][1]) * res[0][1]); o2.y = cvt_pk_bf16(silu_f(res[1][2]) * res[0][2], silu_f(res[1][3]) * res[0][3]);
                    *(u32x2*)(act + (size_t)(row0 + ai * 128 + m * 16) * DFF + ov) = o2;
                }
                asm volatile("" ::: "memory");
            }
        }
#undef XIDX
    }
};
constexpr size_t WS_XCH = 26 * MiB + 512 * 1024;
constexpr size_t WS_CNT = WS_BAR_BASE + 16384;
struct EpiP7 {
    static constexpr bool PERM = false;
    float* out; const bf16* x1b; const float* mod; const float* norm_f; float* xch; unsigned* cnt;
    __device__ __forceinline__ void operator()(f32x4 (&acc)[2][2][4][2], const pg8::Unit& u, int wr, int wc, int fr, int fq, LAS unsigned char* lds) const {
        const int tid = threadIdx.x;
        const int row0 = u.pm * 256 + wr * 64 + fr, b = u.pm >> 3, col0 = u.pn * 256 + wc * 32 + 4 * fq;
        LAS float* red = (LAS float*)(lds + LDS_X);
        LAS float* rsl = red + 1024;
        f32x4 g2[2][2];
#pragma unroll
        for (int bj = 0; bj < 2; ++bj)
#pragma unroll
            for (int n = 0; n < 2; ++n) g2[bj][n] = *(const f32x4*)(mod + b * 6144 + 5120 + col0 + bj * 128 + n * 16);
        u32x2 xb[2][4][2][2];
#pragma unroll
        for (int ai = 0; ai < 2; ++ai)
#pragma unroll
            for (int m = 0; m < 4; ++m)
#pragma unroll
                for (int bj = 0; bj < 2; ++bj)
#pragma unroll
                    for (int n = 0; n < 2; ++n) xb[ai][m][bj][n] = *(const u32x2*)(x1b + (size_t)(u.pm * 256 + ai * 128 + wr * 64 + m * 16 + fr) * DM + col0 + bj * 128 + n * 16);
        asm volatile("" ::: "memory");
#pragma unroll
        for (int ai = 0; ai < 2; ++ai)
#pragma unroll
            for (int m = 0; m < 4; ++m) { const int rl = ai * 128 + wr * 64 + m * 16 + fr; float ss = 0.f;
#pragma unroll
                for (int bj = 0; bj < 2; ++bj)
#pragma unroll
                    for (int n = 0; n < 2; ++n) {
                        const u32x2 xw = xb[ai][m][bj][n];
                        const f32x4 v = (f32x4){bflo(xw.x), bfhi(xw.x), bflo(xw.y), bfhi(xw.y)} + g2[bj][n] * acc[ai][bj][m][n];
                        acc[ai][bj][m][n] = v; ss += (v.x * v.x + v.y * v.y) + (v.z * v.z + v.w * v.w); }
                ss += __shfl_xor(ss, 16); ss += __shfl_xor(ss, 32);
                if (fq == 0) red[rl * 4 + wc] = ss; }
        asm volatile("s_waitcnt lgkmcnt(0)" ::: "memory"); __builtin_amdgcn_s_barrier(); asm volatile("" ::: "memory");
        if (tid < 256) { const f32x4 r4 = *(const LAS f32x4*)(red + tid * 4);
            __hip_atomic_store(xch + (size_t)(u.pm * 256 + tid) * 4 + u.pn, (r4.x + r4.y) + (r4.z + r4.w), __ATOMIC_RELAXED, __HIP_MEMORY_SCOPE_AGENT); }
        asm volatile("s_waitcnt vmcnt(0)" ::: "memory"); __builtin_amdgcn_s_barrier(); asm volatile("" ::: "memory");
        if (tid == 0) { __hip_atomic_fetch_add(cnt + 64 * u.pm, 1u, __ATOMIC_RELAXED, __HIP_MEMORY_SCOPE_AGENT);
            unsigned sp = 0; while (__hip_atomic_load(cnt + 64 * u.pm, __ATOMIC_RELAXED, __HIP_MEMORY_SCOPE_AGENT) < 4u) { __builtin_amdgcn_s_sleep(2); if (++sp > (1u << 22)) break; } }
        asm volatile("s_waitcnt vmcnt(0) lgkmcnt(0)" ::: "memory"); __builtin_amdgcn_s_barrier(); asm volatile("" ::: "memory");
        if (tid < 256) { const float* s = xch + (size_t)(u.pm * 256 + tid) * 4; float t = 0.f;
#pragma unroll
            for (int k = 0; k < 4; ++k) t += __hip_atomic_load(s + k, __ATOMIC_RELAXED, __HIP_MEMORY_SCOPE_AGENT);
            rsl[tid] = rsqrtf(t * (1.0f / DM) + EPS); }
        asm volatile("s_waitcnt vmcnt(0) lgkmcnt(0)" ::: "memory"); __builtin_amdgcn_s_barrier(); asm volatile("" ::: "memory");
        f32x4 nf[2][2];
#pragma unroll
        for (int bj = 0; bj < 2; ++bj)
#pragma unroll
            for (int n = 0; n < 2; ++n) nf[bj][n] = *(const f32x4*)(norm_f + col0 + bj * 128 + n * 16);
#pragma unroll
        for (int ai = 0; ai < 2; ++ai)
#pragma unroll
            for (int m = 0; m < 4; ++m) { const int rl = ai * 128 + wr * 64 + m * 16 + fr; const float rs = rsl[rl];
#pragma unroll
                for (int bj = 0; bj < 2; ++bj)
#pragma unroll
                    for (int n = 0; n < 2; ++n) *(f32x4*)(out + (size_t)(u.pm * 256 + rl) * DM + col0 + bj * 128 + n * 16) = acc[ai][bj][m][n] * rs * nf[bj][n]; }
    }
};
__device__ __forceinline__ float log2_gamma(float logit) { return -log1pf(__expf(-logit)) * 1.4426950408889634f; }

__device__ __forceinline__ void load_qk_rope(const bf16* src, int ld, const f32x2* rope, int tpos, bool do_rope, int dg, float scale, float (&lo)[8], float (&hi)[8]) {
    const u32x4 a = *(const u32x4*)(src + 8 * dg), b = *(const u32x4*)(src + 32 + 8 * dg);
    const unsigned aw[4] = {a.x, a.y, a.z, a.w}, bw[4] = {b.x, b.y, b.z, b.w};
#pragma unroll
    for (int e = 0; e < 4; ++e) { lo[2 * e] = bflo(aw[e]); lo[2 * e + 1] = bfhi(aw[e]); hi[2 * e] = bflo(bw[e]); hi[2 * e + 1] = bfhi(bw[e]); }
    if (do_rope) {
        const f32x4* rp = (const f32x4*)(rope + (size_t)tpos * 32 + 8 * dg);
#pragma unroll
        for (int e = 0; e < 4; ++e) { const f32x4 cs = rp[e];
            float x1 = lo[2 * e], x2 = hi[2 * e]; lo[2 * e] = x1 * cs.x - x2 * cs.y; hi[2 * e] = x1 * cs.y + x2 * cs.x;
            x1 = lo[2 * e + 1]; x2 = hi[2 * e + 1]; lo[2 * e + 1] = x1 * cs.z - x2 * cs.w; hi[2 * e + 1] = x1 * cs.w + x2 * cs.z; }
    }
#pragma unroll
    for (int e = 0; e < 8; ++e) { lo[e] *= scale; hi[e] *= scale; }
}

constexpr int LDK2 = 136;
typedef short s16x4 __attribute__((ext_vector_type(4)));
struct KvRaw { u32x4 ka, kb, v[4]; f32x4 rp[4]; };
__device__ __forceinline__ void kv_issue(const Params& p, int t, int tid, KvRaw& r) {
    const bf16* qkvg = WSP(bf16, WS_QKVG); const bf16* uc = WSP(bf16, WS_UC); const f32x2* rope = WSP(f32x2, WS_ROPE);
    const int bh = t < 512 ? (t >> 4) : ((t - 512) >> 1), ck = t < 512 ? (t & 15) : 16 + ((t - 512) & 1), b = bh >> 2, h = bh & 3; const bool seq = ck < 16;
    const int j = tid >> 2, dg = tid & 3;
    const bf16* ks = seq ? qkvg + (size_t)(b * SEQ + ck * CH + j) * NREST + 256 + h * DK : uc + (size_t)(b * CTXL + (ck - 16) * CH + j) * 768 + h * DK;
    r.ka = *(const u32x4*)(ks + 8 * dg); r.kb = *(const u32x4*)(ks + 32 + 8 * dg);
    const f32x4* rp = (const f32x4*)(rope + (size_t)((ck * CH + j) & (SEQ - 1)) * 32 + 8 * dg);
#pragma unroll
    for (int e = 0; e < 4; ++e) r.rp[e] = rp[e];
#pragma unroll
    for (int q = 0; q < 4; ++q) { const int pc = tid + 512 * q, jv = pc >> 4, eg = pc & 15;
        r.v[q] = *(const u32x4*)(seq ? qkvg + (size_t)(b * SEQ + ck * CH + jv) * NREST + 512 + h * DV + 8 * eg : uc + (size_t)(b * CTXL + (ck - 16) * CH + jv) * 768 + 256 + h * DV + 8 * eg); }
}
__device__ __forceinline__ void phase2(const Params& p, LAS unsigned char* lds) {
    const int tid = threadIdx.x, lane = tid & 63, wave = tid >> 6, G = gridDim.x;
    constexpr int LDKR = 72, LDVR = 136;
    LAS bf16* Kf = (LAS bf16*)lds; LAS bf16* Kb = Kf + 128 * LDKR; LAS bf16* Vr = Kb + 128 * LDKR;
    float* KV = WSP(float, WS_KV);
    constexpr int NT = 32 * 18;
    KvRaw cur; kv_issue(p, blockIdx.x, tid, cur);
    for (int t = blockIdx.x; t < NT; t += G) {
        const int bh = t < 512 ? (t >> 4) : ((t - 512) >> 1), ck = t < 512 ? (t & 15) : 16 + ((t - 512) & 1), h = bh & 3;
        if (t >= 512) {
            if (tid == 0) { unsigned* ctr = WSP(unsigned, WS_ROWCTR); unsigned sp = 0;
                while (__hip_atomic_load(ctr, __ATOMIC_RELAXED, __HIP_MEMORY_SCOPE_AGENT) < 24u) { __builtin_amdgcn_s_sleep(4); if (++sp > (1u << 22)) break; }
                __builtin_amdgcn_fence(__ATOMIC_ACQUIRE, "agent"); asm volatile("s_waitcnt vmcnt(0)" ::: "memory"); }
            __syncthreads();
            kv_issue(p, t, tid, cur); }
        const float l2f = log2_gamma(p.ret_logit_f[h]), l2b = log2_gamma(p.ret_logit_b[h]);
        const bool seq = ck < 16;
        {
            const int j = tid >> 2, dg = tid & 3; float lo[8], hi[8];
            const unsigned aw[4] = {cur.ka.x, cur.ka.y, cur.ka.z, cur.ka.w}, bw[4] = {cur.kb.x, cur.kb.y, cur.kb.z, cur.kb.w};
#pragma unroll
            for (int e = 0; e < 4; ++e) { lo[2 * e] = bflo(aw[e]); lo[2 * e + 1] = bfhi(aw[e]); hi[2 * e] = bflo(bw[e]); hi[2 * e + 1] = bfhi(bw[e]); }
            if (seq) {
#pragma unroll
                for (int e = 0; e < 4; ++e) { const f32x4 cs = cur.rp[e];
                    float x1 = lo[2 * e], x2 = hi[2 * e]; lo[2 * e] = x1 * cs.x - x2 * cs.y; hi[2 * e] = x1 * cs.y + x2 * cs.x;
                    x1 = lo[2 * e + 1]; x2 = hi[2 * e + 1]; lo[2 * e + 1] = x1 * cs.z - x2 * cs.w; hi[2 * e + 1] = x1 * cs.w + x2 * cs.z; } }
            const float wf = 0.125f * exp2f(l2f * (float)(127 - j)), wb = 0.125f * exp2f(l2b * (float)j);
            u32x4 w;
            w.x = cvt_pk_bf16(lo[0] * wf, lo[1] * wf); w.y = cvt_pk_bf16(lo[2] * wf, lo[3] * wf); w.z = cvt_pk_bf16(lo[4] * wf, lo[5] * wf); w.w = cvt_pk_bf16(lo[6] * wf, lo[7] * wf); *(LAS u32x4*)(Kf + j * LDKR + 8 * dg) = w;
            w.x = cvt_pk_bf16(hi[0] * wf, hi[1] * wf); w.y = cvt_pk_bf16(hi[2] * wf, hi[3] * wf); w.z = cvt_pk_bf16(hi[4] * wf, hi[5] * wf); w.w = cvt_pk_bf16(hi[6] * wf, hi[7] * wf); *(LAS u32x4*)(Kf + j * LDKR + 32 + 8 * dg) = w;
            w.x = cvt_pk_bf16(lo[0] * wb, lo[1] * wb); w.y = cvt_pk_bf16(lo[2] * wb, lo[3] * wb); w.z = cvt_pk_bf16(lo[4] * wb, lo[5] * wb); w.w = cvt_pk_bf16(lo[6] * wb, lo[7] * wb); *(LAS u32x4*)(Kb + j * LDKR + 8 * dg) = w;
            w.x = cvt_pk_bf16(hi[0] * wb, hi[1] * wb); w.y = cvt_pk_bf16(hi[2] * wb, hi[3] * wb); w.z = cvt_pk_bf16(hi[4] * wb, hi[5] * wb); w.w = cvt_pk_bf16(hi[6] * wb, hi[7] * wb); *(LAS u32x4*)(Kb + j * LDKR + 32 + 8 * dg) = w;
        }
#pragma unroll
        for (int q = 0; q < 4; ++q) { const int pc = tid + 512 * q, j = pc >> 4, eg = pc & 15; *(LAS u32x4*)(Vr + j * LDVR + 8 * eg) = cur.v[q]; }
        if (t + G < 512) kv_issue(p, t + G, tid, cur);
        __syncthreads();
        {
            const int dir = wave >> 2, e0 = (wave & 3) * 32, fr = lane & 15, fq = lane >> 4;
            const LAS bf16* Kx = dir ? Kb : Kf;
            const int trow = 8 * fq + (fr >> 2), tcol = 4 * (fr & 3);
            f32x4 acc[2][4];
#pragma unroll
            for (int mt = 0; mt < 2; ++mt)
#pragma unroll
                for (int n = 0; n < 4; ++n) acc[mt][n] = (f32x4){0.f, 0.f, 0.f, 0.f};
#pragma unroll
            for (int ks = 0; ks < 4; ++ks) {
                bf16x8 af[2], bfr[4];
#pragma unroll
                for (int mt = 0; mt < 2; ++mt) { const LAS bf16* a = Vr + (32 * ks + trow) * LDVR + e0 + 16 * mt + tcol;
                    const s16x4 t0 = __builtin_amdgcn_ds_read_tr16_b64_v4i16((LAS s16x4*)a), t1 = __builtin_amdgcn_ds_read_tr16_b64_v4i16((LAS s16x4*)(a + 4 * LDVR));
                    af[mt] = (bf16x8){t0.x, t0.y, t0.z, t0.w, t1.x, t1.y, t1.z, t1.w}; }
#pragma unroll
                for (int n = 0; n < 4; ++n) { const LAS bf16* b = Kx + (32 * ks + trow) * LDKR + 16 * n + tcol;
                    const s16x4 t0 = __builtin_amdgcn_ds_read_tr16_b64_v4i16((LAS s16x4*)b), t1 = __builtin_amdgcn_ds_read_tr16_b64_v4i16((LAS s16x4*)(b + 4 * LDKR));
                    bfr[n] = (bf16x8){t0.x, t0.y, t0.z, t0.w, t1.x, t1.y, t1.z, t1.w}; }
#pragma unroll
                for (int mt = 0; mt < 2; ++mt)
#pragma unroll
                    for (int n = 0; n < 4; ++n) acc[mt][n] = __builtin_amdgcn_mfma_f32_16x16x32_bf16(af[mt], bfr[n], acc[mt][n], 0, 0, 0);
            }
            float* dst = KV + ((size_t)(bh * 18 + ck) * 2 + dir) * 8192;
#pragma unroll
            for (int mt = 0; mt < 2; ++mt)
#pragma unroll
                for (int n = 0; n < 4; ++n)
#pragma unroll
                    for (int r = 0; r < 4; ++r) __hip_atomic_store(dst + (e0 + 16 * mt + 4 * fq + r) * 64 + 16 * n + fr, acc[mt][n][r], __ATOMIC_RELAXED, __HIP_MEMORY_SCOPE_AGENT);
        }
        __syncthreads();
    }
}

__device__ __forceinline__ void phase2b(const Params& p) {
    const int half = gridDim.x >> 1; if ((int)blockIdx.x < half) return;
    const int gt = ((int)blockIdx.x - half) * 512 + threadIdx.x, NT = (gridDim.x - half) * 512;
    const float* KV = WSP(float, WS_KV); bf16* Sst = WSP(bf16, WS_SST);
    for (int it = gt; it < 64 * 1024; it += NT) {
        const int bhd = it >> 10, bh = bhd >> 1, dir = bhd & 1, h = bh & 3, off = (it & 1023) * 8;
        const float g128 = exp2f(log2_gamma(dir ? p.ret_logit_b[h] : p.ret_logit_f[h]) * 128.f);
        const float* base = KV + ((size_t)bh * 18 * 2 + dir) * 8192 + off;
        f32x4 v[18][2];
#pragma unroll
        for (int ck = 0; ck < 18; ++ck) { v[ck][0] = *(const f32x4*)(base + (size_t)ck * 2 * 8192); v[ck][1] = *(const f32x4*)(base + (size_t)ck * 2 * 8192 + 4); }
        f32x4 s0, s1;
        if (dir == 0) { s0 = v[16][0] * g128 + v[17][0]; s1 = v[16][1] * g128 + v[17][1]; } else { s0 = v[16][0] + v[17][0] * g128; s1 = v[16][1] + v[17][1] * g128; }
#pragma unroll
        for (int i = 0; i < 16; ++i) { const int c = dir ? 15 - i : i;
            u32x4 w; w.x = cvt_pk_bf16(s0.x, s0.y); w.y = cvt_pk_bf16(s0.z, s0.w); w.z = cvt_pk_bf16(s1.x, s1.y); w.w = cvt_pk_bf16(s1.z, s1.w);
            *(u32x4*)(Sst + (((size_t)bh * 16 + c) * 2 + dir) * 8192 + off) = w;
            const f32x4 k0 = dir ? v[15 - i][0] : v[i][0], k1 = dir ? v[15 - i][1] : v[i][1];
            s0 = s0 * g128 + k0; s1 = s1 * g128 + k1; }
    }
}

constexpr int LDQ = 72, LDV = 136;
constexpr int R_Q = 0, R_K = R_Q + 128 * LDQ * 2, R_VT = R_K + 128 * LDQ * 2, R_SF = R_VT + 128 * LDV * 2, R_SB = R_SF + 128 * LDQ * 2, R_OS = R_SB + 128 * LDQ * 2, R_END = R_OS + 128 * LDV * 2;
static_assert(R_END <= LDS_BYTES, "retention LDS");
__device__ __forceinline__ void ret_task(const Params& p, LAS unsigned char* lds, int t) {
    const int tid = threadIdx.x, lane = tid & 63, wave = tid >> 6;
    LAS bf16* Qs = (LAS bf16*)(lds + R_Q); LAS bf16* Ks = (LAS bf16*)(lds + R_K); LAS bf16* vT = (LAS bf16*)(lds + R_VT);
    LAS bf16* SfT = (LAS bf16*)(lds + R_SF); LAS bf16* SbT = (LAS bf16*)(lds + R_SB); LAS bf16* Os = (LAS bf16*)(lds + R_OS);
    const bf16* qkvg = WSP(bf16, WS_QKVG); const f32x2* rope = WSP(f32x2, WS_ROPE); const float* KV = WSP(float, WS_KV); bf16* ycat = WSP(bf16, WS_YCAT);
    const int bh = t >> 4, c = t & 15, b = bh >> 2, h = bh & 3;
    const float l2f = log2_gamma(p.ret_logit_f[h]), l2b = log2_gamma(p.ret_logit_b[h]);
    const size_t tok0 = (size_t)b * SEQ + c * CH;
    u32x4 gpre[4];
#pragma unroll
    for (int q = 0; q < 4; ++q) { const int pc = tid + 512 * q; gpre[q] = *(const u32x4*)(qkvg + (tok0 + (pc >> 4)) * NREST + 1024 + h * DV + 8 * (pc & 15)); }
    {
        const int j = tid >> 2, dg = tid & 3; float lo[8], hi[8];
        const bf16* src = qkvg + (tok0 + j) * NREST + h * DK;
        load_qk_rope(src, 0, rope, c * CH + j, true, dg, 1.0f, lo, hi);
        u32x4 w; w.x = cvt_pk_bf16(lo[0], lo[1]); w.y = cvt_pk_bf16(lo[2], lo[3]); w.z = cvt_pk_bf16(lo[4], lo[5]); w.w = cvt_pk_bf16(lo[6], lo[7]); *(LAS u32x4*)(Qs + j * LDQ + 8 * dg) = w;
        w.x = cvt_pk_bf16(hi[0], hi[1]); w.y = cvt_pk_bf16(hi[2], hi[3]); w.z = cvt_pk_bf16(hi[4], hi[5]); w.w = cvt_pk_bf16(hi[6], hi[7]); *(LAS u32x4*)(Qs + j * LDQ + 32 + 8 * dg) = w;
        load_qk_rope(src + 256, 0, rope, c * CH + j, true, dg, 0.125f, lo, hi);
        w.x = cvt_pk_bf16(lo[0], lo[1]); w.y = cvt_pk_bf16(lo[2], lo[3]); w.z = cvt_pk_bf16(lo[4], lo[5]); w.w = cvt_pk_bf16(lo[6], lo[7]); *(LAS u32x4*)(Ks + j * LDQ + 8 * dg) = w;
        w.x = cvt_pk_bf16(hi[0], hi[1]); w.y = cvt_pk_bf16(hi[2], hi[3]); w.z = cvt_pk_bf16(hi[4], hi[5]); w.w = cvt_pk_bf16(hi[6], hi[7]); *(LAS u32x4*)(Ks + j * LDQ + 32 + 8 * dg) = w;
    }
#pragma unroll
    for (int q = 0; q < 4; ++q) {
        const int pc = tid + 512 * q, j = pc >> 4, eg = pc & 15;
        const u32x4 a = *(const u32x4*)(qkvg + (tok0 + j) * NREST + 512 + h * DV + 8 * eg); const unsigned aw[4] = {a.x, a.y, a.z, a.w};
#pragma unroll
        for (int e = 0; e < 4; ++e) { vT[(8 * eg + 2 * e) * LDV + (j ^ (eg << 3))] = (bf16)(aw[e] & 0xffffu); vT[(8 * eg + 2 * e + 1) * LDV + (j ^ (eg << 3))] = (bf16)(aw[e] >> 16); }
    }
    {
        const bf16* sst = WSP(bf16, WS_SST) + ((size_t)bh * 16 + c) * 2 * 8192;
#pragma unroll
        for (int q = 0; q < 2; ++q) { const int pc = tid + 512 * q, e = pc >> 3, d0 = (pc & 7) * 8;
            *(LAS u32x4*)(SfT + e * LDQ + d0) = *(const u32x4*)(sst + pc * 8);
            *(LAS u32x4*)(SbT + e * LDQ + d0) = *(const u32x4*)(sst + 8192 + pc * 8); }
    }
    __syncthreads();
    {
        const int fr = lane & 15, fq = lane >> 4, iloc = 16 * wave + fr;
        bf16x8 qf[2], qF[2], qB[2];
#pragma unroll
        for (int ks = 0; ks < 2; ++ks) qf[ks] = *(const LAS bf16x8*)(Qs + iloc * LDQ + 32 * ks + 8 * fq);
        {
            const float sF = exp2f(l2f * (float)(iloc + 1)), sB = exp2f(l2b * (float)(128 - iloc));
#pragma unroll
            for (int ks = 0; ks < 2; ++ks) { union { bf16x8 v; unsigned u[4]; } in, oF, oB; in.v = qf[ks];
#pragma unroll
                for (int e = 0; e < 4; ++e) { const float a = bflo(in.u[e]), bb = bfhi(in.u[e]); oF.u[e] = cvt_pk_bf16(a * sF, bb * sF); oB.u[e] = cvt_pk_bf16(a * sB, bb * sB); }
                qF[ks] = oF.v; qB[ks] = oB.v; }
        }
        f32x4 sacc[8];
#pragma unroll
        for (int jt = 0; jt < 8; ++jt) { sacc[jt] = (f32x4){0.f, 0.f, 0.f, 0.f};
#pragma unroll
            for (int ks = 0; ks < 2; ++ks) { const bf16x8 kf = *(const LAS bf16x8*)(Ks + (16 * jt + fr) * LDQ + 32 * ks + 8 * fq);
                sacc[jt] = __builtin_amdgcn_mfma_f32_16x16x32_bf16(kf, qf[ks], sacc[jt], 0, 0, 0); } }
        bf16x8 pf[4];
#pragma unroll
        for (int ks = 0; ks < 4; ++ks) { union { bf16x8 v; unsigned u[4]; } o;
#pragma unroll
            for (int half = 0; half < 2; ++half) { const int jt = 2 * ks + half; float pv[4];
#pragma unroll
                for (int r = 0; r < 4; ++r) { const int diff = iloc - (16 * jt + 4 * fq + r); const float dm = diff >= 0 ? exp2f(l2f * (float)diff) : exp2f(l2b * (float)(-diff)); pv[r] = sacc[jt][r] * dm; }
                o.u[2 * half] = cvt_pk_bf16(pv[0], pv[1]); o.u[2 * half + 1] = cvt_pk_bf16(pv[2], pv[3]); }
            pf[ks] = o.v; }
        f32x4 oacc[8];
#pragma unroll
        for (int nt = 0; nt < 8; ++nt) { oacc[nt] = (f32x4){0.f, 0.f, 0.f, 0.f};
            const LAS bf16* vrow = vT + (16 * nt + fr) * LDV; const int sw = (((16 * nt + fr) >> 3) & 15) << 3;
#pragma unroll
            for (int ks = 0; ks < 4; ++ks) { union { bf16x8 v; u32x2 h[2]; } bv; bv.h[0] = *(const LAS u32x2*)(vrow + ((32 * ks + 4 * fq) ^ sw)); bv.h[1] = *(const LAS u32x2*)(vrow + ((32 * ks + 16 + 4 * fq) ^ sw));
                oacc[nt] = __builtin_amdgcn_mfma_f32_16x16x32_bf16(pf[ks], bv.v, oacc[nt], 0, 0, 0); }
#pragma unroll
            for (int ks = 0; ks < 2; ++ks) { const bf16x8 sfv = *(const LAS bf16x8*)(SfT + (16 * nt + fr) * LDQ + 32 * ks + 8 * fq), sbv = *(const LAS bf16x8*)(SbT + (16 * nt + fr) * LDQ + 32 * ks + 8 * fq);
                oacc[nt] = __builtin_amdgcn_mfma_f32_16x16x32_bf16(qF[ks], sfv, oacc[nt], 0, 0, 0);
                oacc[nt] = __builtin_amdgcn_mfma_f32_16x16x32_bf16(qB[ks], sbv, oacc[nt], 0, 0, 0); } }
        float rs[4];
#pragma unroll
        for (int r = 0; r < 4; ++r) { float ss = 0.f;
#pragma unroll
            for (int nt = 0; nt < 8; ++nt) ss += oacc[nt][r] * oacc[nt][r];
            ss += __shfl_xor(ss, 1); ss += __shfl_xor(ss, 2); ss += __shfl_xor(ss, 4); ss += __shfl_xor(ss, 8);
            rs[r] = rsqrtf(ss * (1.0f / DV) + EPS); }
#pragma unroll
        for (int nt = 0; nt < 8; ++nt)
#pragma unroll
            for (int r = 0; r < 4; ++r) Os[(16 * wave + 4 * fq + r) * LDV + 16 * nt + fr] = f2bf(oacc[nt][r] * rs[r]);
    }
    __syncthreads();
#pragma unroll
    for (int q = 0; q < 4; ++q) {
        const int pc = tid + 512 * q, i = pc >> 4, eg = pc & 15;
        const u32x4 o = *(const LAS u32x4*)(Os + i * LDV + 8 * eg), g = gpre[q];
        const unsigned ow[4] = {o.x, o.y, o.z, o.w}, gw[4] = {g.x, g.y, g.z, g.w}; unsigned rw[4];
#pragma unroll
        for (int e = 0; e < 4; ++e) rw[e] = cvt_pk_bf16(silu_f(bflo(gw[e])) * bflo(ow[e]), silu_f(bfhi(gw[e])) * bfhi(ow[e]));
        *(u32x4*)(ycat + (tok0 + i) * DM + 512 + h * DV + 8 * eg) = (u32x4){rw[0], rw[1], rw[2], rw[3]};
    }
    __syncthreads();
}

#ifndef MK_HYLOOP2
#define MK_HYLOOP2 0
#endif
constexpr int U_ROWB = 80, U_BLKB = 8 * U_ROWB, U_PAD = 7, U_BYTES = (64 + 2 * U_PAD) * U_BLKB;
constexpr int CP_STRIDE = 8192 + 64, H_U = 0, H_CP = U_BYTES, H_KS = H_CP + 8 * CP_STRIDE, H_END = H_KS + 8192 + 16;
static_assert(H_END <= LDS_BYTES && (H_CP % 16) == 0 && (H_KS % 16) == 0, "hyena LDS");
__device__ __forceinline__ void hyena_task(const Params& p, LAS unsigned char* lds, int ch) {
    const int tid = threadIdx.x, lane = tid & 63, wave = tid >> 6;
    const bf16* zT = WSP(bf16, WS_ZT); const bf16* kern = WSP(bf16, WS_FILT); bf16* yT = WSP(bf16, WS_YT);
    for (int i = tid; i < 2 * U_PAD * U_BLKB / 16; i += 512) { const int off = (i < U_PAD * U_BLKB / 16) ? i * 16 : (64 + U_PAD) * U_BLKB + (i - U_PAD * U_BLKB / 16) * 16; *(LAS u32x4*)(lds + H_U + off) = (u32x4){0u, 0u, 0u, 0u}; }
    {
        const float w0 = p.hy_conv_w[ch], w1 = p.hy_conv_w[HYC + ch], w2 = p.hy_conv_w[2 * HYC + ch], cb = p.hy_conv_b[ch];
        const bf16* zr = zT + (size_t)ch * M_TOK;
#pragma unroll
        for (int q = 0; q < 4; ++q) { const int pc = tid + 512 * q, b = pc >> 8, t0 = 8 * (pc & 255);
            const bf16* s = zr + b * SEQ + t0; const u32x4 a = *(const u32x4*)s; const unsigned aw[4] = {a.x, a.y, a.z, a.w};
            const float xl_ = bf2f(s[t0 > 0 ? -1 : 0]), xr_ = bf2f(s[t0 + 8 < SEQ ? 8 : 7]);
            float xv[10]; xv[0] = t0 > 0 ? xl_ : 0.f; xv[9] = t0 + 8 < SEQ ? xr_ : 0.f;
#pragma unroll
            for (int e = 0; e < 4; ++e) { xv[1 + 2 * e] = bflo(aw[e]); xv[2 + 2 * e] = bfhi(aw[e]); }
            float o[8];
#pragma unroll
            for (int e = 0; e < 8; ++e) o[e] = w0 * xv[e] + w1 * xv[e + 1] + w2 * xv[e + 2] + cb;
            u32x4 w; w.x = cvt_pk_bf16(o[0], o[1]); w.y = cvt_pk_bf16(o[2], o[3]); w.z = cvt_pk_bf16(o[4], o[5]); w.w = cvt_pk_bf16(o[6], o[7]);
            *(LAS u32x4*)(lds + H_U + ((t0 >> 5) + U_PAD) * U_BLKB + b * U_ROWB + (t0 & 31) * 2) = w; }
    }
    const int a_ = lane & 31, hh = lane >> 5;
    unsigned ypk[2][8];
    for (int o = 0; o < 2; ++o) {
        { const u32x4 kw = *(const u32x4*)(kern + ((size_t)(o * 512 + ch)) * 4096 + tid * 8);
          u32x4 rv; rv.x = (kw.w >> 16) | (kw.w << 16); rv.y = (kw.z >> 16) | (kw.z << 16); rv.z = (kw.y >> 16) | (kw.y << 16); rv.w = (kw.x >> 16) | (kw.x << 16);
          *(LAS u32x4*)(lds + H_KS + (511 - tid) * 16) = rv;
          if (tid == 0) *(LAS u32x4*)(lds + H_KS + 8192) = (u32x4){0u, 0u, 0u, 0u}; }
        __syncthreads();
        {
            const u32x4 lo = *(const LAS u32x4*)(lds + H_KS + tid * 16), hi = *(const LAS u32x4*)(lds + H_KS + tid * 16 + 16);
            const unsigned w[8] = {lo.x, lo.y, lo.z, lo.w, hi.x, hi.y, hi.z, hi.w};
#pragma unroll
            for (int s = 0; s < 8; ++s) { unsigned ow[4];
#pragma unroll
                for (int i = 0; i < 4; ++i) ow[i] = (s & 1) ? __builtin_amdgcn_alignbit(w[i + (s + 1) / 2], w[i + (s - 1) / 2], 16) : w[i + s / 2];
                *(LAS u32x4*)(lds + H_CP + s * CP_STRIDE + tid * 16) = (u32x4){ow[0], ow[1], ow[2], ow[3]}; }
        }
        __syncthreads();
        f32x16 acc[2];
#pragma unroll
        for (int i = 0; i < 16; ++i) { acc[0][i] = 0.f; acc[1][i] = 0.f; }
        u32x2 gxw[2][4]; float gxl[2][4], gxr[2][4];
        {
            const bf16* xr = zT + (size_t)(512 * (o + 1) + ch) * M_TOK + (lane & 7) * SEQ;
#pragma unroll
            for (int I2 = 0; I2 < 2; ++I2)
#pragma unroll
                for (int g4 = 0; g4 < 4; ++g4) { const int pos = 32 * (4 * (2 * wave + I2) + (a_ >> 3)) + 8 * g4 + 4 * hh;
                    gxw[I2][g4] = *(const u32x2*)(xr + pos); gxl[I2][g4] = bf2f(xr[pos > 0 ? pos - 1 : 0]); gxr[I2][g4] = bf2f(xr[pos + 4 < SEQ ? pos + 4 : pos]); }
        }
        {
            const int sg = 7 - (a_ & 7);
            const int abase = H_CP + sg * CP_STRIDE + (255 - (a_ >> 3) + hh) * 16;
            const int bbase = H_U + a_ * U_ROWB + 16 * hh + (8 * wave + U_PAD) * U_BLKB;
            const int dlo = 8 * wave - 63;
            bf16x8 rb[4][2];
#pragma unroll
            for (int s = 0; s < 4; ++s) { const LAS unsigned char* bp = lds + bbase - U_BLKB * (dlo - 4 + s); rb[s][0] = *(const LAS bf16x8*)bp; rb[s][1] = *(const LAS bf16x8*)(bp + 32); }
            bf16x8 ca0, ca1, cn0, cn1;
            { const LAS unsigned char* ap = lds + abase - 64 * dlo; const LAS unsigned char* bp = lds + bbase - U_BLKB * dlo;
              ca0 = *(const LAS bf16x8*)ap; ca1 = *(const LAS bf16x8*)(ap + 32); cn0 = *(const LAS bf16x8*)bp; cn1 = *(const LAS bf16x8*)(bp + 32); }
#define HY_STEP(d_, s_, PF) do { const int d = (d_); bf16x8 na0, na1, nn0, nn1; \
                if (PF) { const LAS unsigned char* ap = lds + abase - 64 * (d + 1); const LAS unsigned char* bp = lds + bbase - U_BLKB * (d + 1); \
                    na0 = *(const LAS bf16x8*)ap; na1 = *(const LAS bf16x8*)(ap + 32); nn0 = *(const LAS bf16x8*)bp; nn1 = *(const LAS bf16x8*)(bp + 32); } \
                acc[1] = __builtin_amdgcn_mfma_f32_32x32x16_bf16(ca0, rb[s_][0], acc[1], 0, 0, 0); \
                acc[0] = __builtin_amdgcn_mfma_f32_32x32x16_bf16(ca0, cn0, acc[0], 0, 0, 0); \
                acc[1] = __builtin_amdgcn_mfma_f32_32x32x16_bf16(ca1, rb[s_][1], acc[1], 0, 0, 0); \
                acc[0] = __builtin_amdgcn_mfma_f32_32x32x16_bf16(ca1, cn1, acc[0], 0, 0, 0); \
                rb[s_][0] = cn0; rb[s_][1] = cn1; if (PF) { ca0 = na0; ca1 = na1; cn0 = nn0; cn1 = nn1; } } while (0)
            for (int dd = 0; dd < 68; dd += 4) { HY_STEP(dlo + dd, 0, true); HY_STEP(dlo + dd + 1, 1, true); HY_STEP(dlo + dd + 2, 2, true); HY_STEP(dlo + dd + 3, 3, true); }
            HY_STEP(dlo + 68, 0, true); HY_STEP(dlo + 69, 1, true); HY_STEP(dlo + 70, 2, false);
#if MK_HYLOOP2
            { f32x16 sv0 = acc[0], sv1 = acc[1];
              { const LAS unsigned char* ap = lds + abase - 64 * dlo; const LAS unsigned char* bp = lds + bbase - U_BLKB * dlo;
                ca0 = *(const LAS bf16x8*)ap; ca1 = *(const LAS bf16x8*)(ap + 32); cn0 = *(const LAS bf16x8*)bp; cn1 = *(const LAS bf16x8*)(bp + 32); }
              for (int dd = 0; dd < 68; dd += 4) { HY_STEP(dlo + dd, 0, true); HY_STEP(dlo + dd + 1, 1, true); HY_STEP(dlo + dd + 2, 2, true); HY_STEP(dlo + dd + 3, 3, true); }
              HY_STEP(dlo + 68, 0, true); HY_STEP(dlo + 69, 1, true); HY_STEP(dlo + 70, 2, false);
#pragma unroll
              for (int i = 0; i < 16; ++i) { acc[0][i] = sv0[i] + 0.0f * acc[0][i]; acc[1][i] = sv1[i] + 0.0f * acc[1][i]; } }
#endif
#undef HY_STEP
        }
        {
            const int b = lane & 7, jj = a_ >> 3, colx = 512 * (o + 1) + ch;
            const float w0 = p.hy_conv_w[colx], w1 = p.hy_conv_w[HYC + colx], w2 = p.hy_conv_w[2 * HYC + colx], cb = p.hy_conv_b[colx], sk = p.hy_bias[o * 512 + ch];
            const bf16* xr = zT + (size_t)colx * M_TOK + b * SEQ;
#pragma unroll
            for (int I2 = 0; I2 < 2; ++I2) { const int blk = 4 * (2 * wave + I2) + jj;
#pragma unroll
                for (int g4 = 0; g4 < 4; ++g4) { const int aa = 8 * g4 + 4 * hh, pos = 32 * blk + aa;
                    const u32x2 uw = *(const LAS u32x2*)(lds + H_U + (blk + U_PAD) * U_BLKB + b * U_ROWB + aa * 2);
                    const u32x2 xw = gxw[I2][g4];
                    float xv[6]; xv[0] = pos > 0 ? gxl[I2][g4] : 0.f; xv[5] = pos + 4 < SEQ ? gxr[I2][g4] : 0.f;
                    xv[1] = bflo(xw.x); xv[2] = bfhi(xw.x); xv[3] = bflo(xw.y); xv[4] = bfhi(xw.y);
                    const float uv[4] = {bflo(uw.x), bfhi(uw.x), bflo(uw.y), bfhi(uw.y)}; float y[4];
#pragma unroll
                    for (int e = 0; e < 4; ++e) { const float gate = w0 * xv[e] + w1 * xv[e + 1] + w2 * xv[e + 2] + cb; y[e] = gate * (acc[I2][4 * g4 + e] + sk * uv[e]); }
                    const unsigned p0 = cvt_pk_bf16(y[0], y[1]), p1 = cvt_pk_bf16(y[2], y[3]);
                    if (o == 0) { ypk[I2][2 * g4] = p0; ypk[I2][2 * g4 + 1] = p1; }
                    else *(u32x2*)(yT + (size_t)ch * M_TOK + b * SEQ + pos) = (u32x2){p0, p1}; } }
        }
        __syncthreads();
        if (o == 0) {
            const int b = lane & 7, jj = a_ >> 3;
#pragma unroll
            for (int I2 = 0; I2 < 2; ++I2) { const int blk = 4 * (2 * wave + I2) + jj;
#pragma unroll
                for (int g4 = 0; g4 < 4; ++g4) { const int aa = 8 * g4 + 4 * hh;
                    *(LAS u32x2*)(lds + H_U + (blk + U_PAD) * U_BLKB + b * U_ROWB + aa * 2) = (u32x2){ypk[I2][2 * g4], ypk[I2][2 * g4 + 1]}; } }
        }
    }
    __syncthreads();
}

__device__ __forceinline__ void phase3c(const Params& p, LAS unsigned char* lds) {
    const int tid = threadIdx.x, lane = tid & 63, wave = tid >> 6, G = gridDim.x;
    LAS bf16* tl = (LAS bf16*)(lds + wave * 16384);
    const bf16* yT = WSP(bf16, WS_YT); bf16* ycat = WSP(bf16, WS_YCAT);
    for (int it = blockIdx.x * 8 + wave; it < 8 * 256; it += G * 8) {
        const int cb = it >> 8, tb = it & 255;
#pragma unroll
        for (int q = 0; q < 8; ++q) { const int pc = lane + 64 * q, r = pc >> 3, c8 = pc & 7;
            *(LAS u32x4*)(tl + r * 72 + 8 * c8) = *(const u32x4*)(yT + (size_t)(64 * cb + r) * M_TOK + 64 * tb + 8 * c8); }
        LDS_WAIT(); asm volatile("" ::: "memory");
#pragma unroll
        for (int q = 0; q < 8; ++q) { const int pc = lane + 64 * q, tk = pc >> 3, c8 = pc & 7; unsigned w[4];
#pragma unroll
            for (int e = 0; e < 4; ++e) w[e] = (unsigned)tl[(8 * c8 + 2 * e) * 72 + tk] | ((unsigned)tl[(8 * c8 + 2 * e + 1) * 72 + tk] << 16);
            *(u32x4*)(ycat + (size_t)(64 * tb + tk) * DM + 64 * cb + 8 * c8) = (u32x4){w[0], w[1], w[2], w[3]}; }
        LDS_WAIT(); asm volatile("" ::: "memory");
    }
}

__device__ __forceinline__ void p6_row(const u32x4 (&v)[3], const u32x4 (&g)[3], const float (&wv)[3][8], const float (&wg)[3][8], const float (&bvv)[8], const float (&bgg)[8], bf16* dst) {
    unsigned ow[4];
#pragma unroll
    for (int e = 0; e < 4; ++e) {
        float v0 = bvv[2 * e], v1 = bvv[2 * e + 1], q0 = bgg[2 * e], q1 = bgg[2 * e + 1];
#pragma unroll
        for (int k = 0; k < 3; ++k) { const unsigned a = v[k][e], b = g[k][e];
            v0 += wv[k][2 * e] * bflo(a); v1 += wv[k][2 * e + 1] * bfhi(a); q0 += wg[k][2 * e] * bflo(b); q1 += wg[k][2 * e + 1] * bfhi(b); }
        ow[e] = cvt_pk_bf16(silu_f(q0) * v0, silu_f(q1) * v1); }
    *(u32x4*)dst = (u32x4){ow[0], ow[1], ow[2], ow[3]};
}
__device__ __forceinline__ void ffn_edge_rows(const Params& p, int pm) {
    bf16* act = WSP(bf16, WS_APRE); const bf16* halo4 = WSP(bf16, WS_HALO);
    for (int t = threadIdx.x; t < 704; t += 512) {
        const int which = t / 352, cg = t % 352, pn = cg >> 4, j0 = (cg & 15) * 8;
        const int cv = 256 * pn + j0, cgt = cv + 128, ov = 128 * pn + j0, og = DFF + ov;
        float wv[3][8], wg[3][8], bvv[8], bgg[8];
#pragma unroll
        for (int e = 0; e < 8; ++e) { bvv[e] = p.ffn_conv_b[ov + e]; bgg[e] = p.ffn_conv_b[og + e];
#pragma unroll
            for (int k = 0; k < 3; ++k) { wv[k][e] = p.ffn_conv_w[k * NUP + ov + e]; wg[k][e] = p.ffn_conv_w[k * NUP + og + e]; } }
        const u32x4 zero = (u32x4){0u, 0u, 0u, 0u};
        const bf16* hm = halo4 + (size_t)pm * 4 * NUP;
        u32x4 v3[3], g3[3];
        if (which == 0) {
            if (pm & 7) { v3[0] = *(const u32x4*)(hm - NUP + cv); g3[0] = *(const u32x4*)(hm - NUP + cgt); } else { v3[0] = zero; g3[0] = zero; }
            v3[1] = *(const u32x4*)(hm + cv); g3[1] = *(const u32x4*)(hm + cgt); v3[2] = *(const u32x4*)(hm + NUP + cv); g3[2] = *(const u32x4*)(hm + NUP + cgt);
        } else {
            v3[0] = *(const u32x4*)(hm + 2 * NUP + cv); g3[0] = *(const u32x4*)(hm + 2 * NUP + cgt); v3[1] = *(const u32x4*)(hm + 3 * NUP + cv); g3[1] = *(const u32x4*)(hm + 3 * NUP + cgt);
            if ((pm & 7) != 7) { v3[2] = *(const u32x4*)(hm + 4 * NUP + cv); g3[2] = *(const u32x4*)(hm + 4 * NUP + cgt); } else { v3[2] = zero; g3[2] = zero; }
        }
        p6_row(v3, g3, wv, wg, bvv, bgg, act + (size_t)(256 * pm + (which ? 255 : 0)) * DFF + ov);
    }
}

__device__ __forceinline__ void phase8(const Params& p, float* wout) {
    const int tid = threadIdx.x, lane = tid & 63, wave = tid >> 6, G = gridDim.x;
    const float* ssq = WSP(float, WS_SUMSQ) + M_TOK;
    for (int m = blockIdx.x * 8 + wave; m < M_TOK; m += G * 8) {
        const float rs = rsqrtf(ssq[m] * (1.0f / DM) + EPS); f32x4* row = (f32x4*)(p.out + (size_t)m * DM);
        f32x4* wrow = (f32x4*)(wout + (size_t)m * DM);
#pragma unroll
        for (int j = 0; j < 4; ++j) { const int c4 = lane + 64 * j; wrow[c4] = row[c4] * rs * ((const f32x4*)p.norm_f)[c4]; }
    }
}
#ifndef MK_DEBUG
#define MK_DEBUG 0
#endif
#ifndef MK_TIMING
#define MK_TIMING 0
#endif
#ifndef MK_KA
#define MK_KA 0
#define MK_KB 1
#endif
constexpr size_t WS_TS = 25 * MiB + 900 * 1024;
constexpr size_t WS_BAR = WS_BAR_BASE;
constexpr int LDS_MISC = LDS_BYTES - 64;
#define XB_TMO      128
#define XB_XCNT(j)  (256  + 64 * (j))
#define XB_XSUB(j)  (1280 + 64 * (j))
#define XB_XGEN(j)  (2304 + 64 * (j))
#define XB_TOP      3328
#define XB_TOPGEN   3392
#define XCD_BAR_WORDS 3456
#define XB_SPIN_CAP (1u << 22)
__device__ __forceinline__ unsigned xb_ld(unsigned* p)              { return __hip_atomic_load(p, __ATOMIC_RELAXED, __HIP_MEMORY_SCOPE_AGENT); }
__device__ __forceinline__ unsigned xb_add(unsigned* p, unsigned v) { return __hip_atomic_fetch_add(p, v, __ATOMIC_RELAXED, __HIP_MEMORY_SCOPE_AGENT); }
__device__ __forceinline__ unsigned xb_xcc_id() { return (unsigned)__builtin_amdgcn_s_getreg((3 << 11) | 20) & 0xFu; }
#define XB_SPIN(cond, bar) do { unsigned _sp = 0; while (cond) { __builtin_amdgcn_s_sleep(1); \
    if ((++_sp & 255u) == 0u) { if (xb_ld(&(bar)[XB_TMO])) break; if (_sp > XB_SPIN_CAP) { atomicAdd(&(bar)[XB_TMO], 1u); break; } } } } while (0)
struct XcdBarrier { unsigned* bar; unsigned x; volatile LAS unsigned* st; };
__device__ __forceinline__ XcdBarrier xcd_barrier_post(unsigned* bar, volatile LAS unsigned* st) {
    XcdBarrier b; b.bar = bar; b.x = xb_xcc_id(); b.st = st;
    if (threadIdx.x == 0) (void)xb_add(&bar[XB_XCNT(b.x)], 1u);
    return b;
}
__device__ __forceinline__ void xcd_barrier_complete(unsigned* bar, unsigned x, unsigned& nloc, unsigned& nx) {
    const unsigned G = gridDim.x * gridDim.y * gridDim.z;
    unsigned sum, cnt, mine, sp = 0u;
    for (;;) {
        sum = 0u; cnt = 0u; mine = 0u;
#pragma unroll
        for (unsigned j = 0; j < 16; ++j) { const unsigned c = xb_ld(&bar[XB_XCNT(j)]); sum += c; cnt += (c > 0u) ? 1u : 0u; mine = (j == x) ? c : mine; }
        if (sum == G) break;
        __builtin_amdgcn_s_sleep(1);
        if ((++sp & 255u) == 0u) { if (xb_ld(&bar[XB_TMO])) break; if (sp > XB_SPIN_CAP) { atomicAdd(&bar[XB_TMO], 1u); break; } }
    }
    nloc = mine > 0u ? mine : 1u; nx = cnt > 0u ? cnt : 1u;
}
__device__ __forceinline__ void xcd_barrier(const XcdBarrier& b) {
    asm volatile("s_waitcnt vmcnt(0)" ::: "memory");
    __syncthreads();
    if (threadIdx.x == 0) {
        unsigned* bar = b.bar;
        __builtin_amdgcn_s_waitcnt(0);
        unsigned nloc = b.st[0], nx = b.st[1];
        if (nloc == 0u) { xcd_barrier_complete(bar, b.x, nloc, nx); b.st[0] = nloc; b.st[1] = nx; }
        const unsigned old = xb_add(&bar[XB_XSUB(b.x)], 1u);
        const unsigned gen = old / nloc;
        if (old + 1u == (gen + 1u) * nloc) {
            __builtin_amdgcn_fence(__ATOMIC_RELEASE, "agent");
            asm volatile("s_waitcnt vmcnt(0)" ::: "memory");
            const unsigned og = xb_add(&bar[XB_TOP], 1u);
            const unsigned tg = og / nx;
            if (og + 1u == (tg + 1u) * nx) xb_add(&bar[XB_TOPGEN], 1u);
            else XB_SPIN(xb_ld(&bar[XB_TOPGEN]) == tg, bar);
            __builtin_amdgcn_fence(__ATOMIC_ACQUIRE, "agent");
            xb_add(&bar[XB_XGEN(b.x)], 1u);
            asm volatile("s_waitcnt vmcnt(0)" ::: "memory");
        } else {
            XB_SPIN(xb_ld(&bar[XB_XGEN(b.x)]) == gen, bar);
            __builtin_amdgcn_fence(__ATOMIC_ACQUIRE, "agent");
            asm volatile("s_waitcnt vmcnt(0)" ::: "memory");
        }
    }
    __syncthreads();
}
#ifndef MK_CGSYNC
#define MK_CGSYNC 0
#endif
#ifndef MK_REP_P0A
#define MK_REP_P0A 1
#endif
#ifndef MK_REP_P0B
#define MK_REP_P0B 1
#endif
#ifndef MK_REP_P2
#define MK_REP_P2 1
#endif
#ifndef MK_REP_P3C
#define MK_REP_P3C 1
#endif
#ifndef MK_REP_P5
#define MK_REP_P5 1
#endif
#ifndef MK_REP_P56
#define MK_REP_P56 1
#endif
#ifndef MK_REP_P1
#define MK_REP_P1 1
#endif
#ifndef MK_REP_CTX
#define MK_REP_CTX 1
#endif
#ifndef MK_REP_P4
#define MK_REP_P4 1
#endif
#ifndef MK_REP_P7
#define MK_REP_P7 1
#endif
#ifndef MK_REP_P8
#define MK_REP_P8 1
#endif
#ifndef MK_PASSES
#define MK_PASSES 1
#endif
#ifndef MK_TILESYNC
#define MK_TILESYNC 0
#endif
#ifndef MK_P5_SP2
#define MK_P5_SP2 1
#endif
#ifndef MK_REP_HY
#define MK_REP_HY 1
#endif
#ifndef MK_REP_RET
#define MK_REP_RET 1
#endif
#ifndef MK_EXTRA_SYNC
#define MK_EXTRA_SYNC 0
#endif
#ifndef MK_MULTI
#define MK_MULTI 0
#endif
constexpr int N_PHASES = 9;
__global__ void __launch_bounds__(512, 2) fwd_kernel(Params p) {
    extern __shared__ __attribute__((aligned(16))) unsigned char lds_raw[];
    LAS unsigned char* lds = (LAS unsigned char*)lds_raw;
    cg::grid_group grid = cg::this_grid();
    const int G = gridDim.x, bx = blockIdx.x;
#define IN(k) (p.ph_lo <= (k) && (k) < p.ph_hi)
    if (threadIdx.x < 2) ((volatile LAS unsigned*)(lds + LDS_MISC))[threadIdx.x] = 0u;
    __syncthreads();
    const bool TILE_SYNC = (G == 256) && MK_TILESYNC; int tile_pm, tile_pn; pg8::order_tile<64, 4>(bx & 255, tile_pm, tile_pn);
    const XcdBarrier xbar = xcd_barrier_post(WSP(unsigned, WS_BAR), (volatile LAS unsigned*)(lds + LDS_MISC));
    if (p.ph_hi < 0) grid.sync();
#define SEAM(k) do { if (IN(k) && IN((k) + 1)) { if (MK_CGSYNC) grid.sync(); else xcd_barrier(xbar); } } while (0)
#if MK_DEBUG
#define DBG(call) do { call; grid.sync(); } while (0)
    if (bx == 0 && threadIdx.x < 16) WSP(unsigned, WS_DBG)[threadIdx.x] = 0u;
#else
#define DBG(call) do { } while (0)
#endif
#if MK_TIMING
#define STAMP(k) do { if (bx == 0 && threadIdx.x == 0) WSP(unsigned long long, WS_TS)[k] = __builtin_amdgcn_s_memrealtime(); } while (0)
#else
#define STAMP(k) do { } while (0)
#endif
    STAMP(0);
    if (IN(0)) for (int rep = 0; rep < MK_REP_P0A; ++rep) { phase0a(p, lds); __syncthreads(); }
    STAMP(1);
    DBG(chk_p0a(p));
    if (IN(1)) { EpiP1 E0{WSP(bf16, WS_ZT), WSP(bf16, WS_QKVG), WSP(bf16, WS_UC)}; phase0b<EpiP1>(p, lds, E0); }
    SEAM(1); STAMP(2);
    if (IN(2)) {
        pg8::Gemm g{DM, DM, DM, 256};
        SchedP1 S{(const char*)WSP(bf16, WS_WINT), (const char*)WSP(bf16, WS_H), (const char*)WSP(bf16, WS_HC), G, bx};
        EpiP1 E{WSP(bf16, WS_ZT), WSP(bf16, WS_QKVG), WSP(bf16, WS_UC)};
        for (int rep = 0; rep < MK_REP_P1; ++rep) pg8::gemm_phase<EpiP1, SchedP1>(lds, g, S, E);
    }
    SEAM(2); STAMP(3);
    DBG(chk_p1(p));
    if (IN(3)) {
        if (bx >= 64 && bx < 88) {
            int pm, pn; pg8::order_tile<8, 3>(bx - 64, pm, pn);
            pg8::Gemm g{DM, DM, DM, 256};
            SchedOne S1{(const char*)WSP(bf16, WS_HC) + (size_t)pm * 256 * DM * 2, (const char*)WSP(bf16, WS_WINT) + (size_t)(7 + pn) * 256 * DM * 2, pm, pn, 2};
            EpiP1 E1{WSP(bf16, WS_ZT), WSP(bf16, WS_QKVG), WSP(bf16, WS_UC)};
            pg8::gemm_phase<EpiP1, SchedOne>(lds, g, S1, E1);
            asm volatile("s_waitcnt vmcnt(0)" ::: "memory"); __syncthreads();
            if (threadIdx.x == 0) { __builtin_amdgcn_fence(__ATOMIC_RELEASE, "agent"); asm volatile("s_waitcnt vmcnt(0)" ::: "memory");
                __hip_atomic_fetch_add(WSP(unsigned, WS_ROWCTR), 1u, __ATOMIC_RELAXED, __HIP_MEMORY_SCOPE_AGENT); }
        }
        for (int rep = 0; rep < MK_REP_P2; ++rep) phase2(p, lds);
        asm volatile("s_waitcnt vmcnt(0)" ::: "memory"); __syncthreads();
        if (threadIdx.x == 0) __hip_atomic_fetch_add(WSP(unsigned, WS_CNT5), 1u, __ATOMIC_RELAXED, __HIP_MEMORY_SCOPE_AGENT);
        for (int rep = 0; rep < MK_REP_HY; ++rep) for (int t = bx; t < 512; t += G) hyena_task(p, lds, t);
        if (bx >= 88) transposes_late(p, lds, (bx - 88) * 8 + (threadIdx.x >> 6), (G - 88) * 8);
        tile_wait(WSP(unsigned, WS_CNT5), nullptr, nullptr, (unsigned)G);
        phase2b(p);
    }
    SEAM(3); STAMP(4);
    if (IN(4)) {
        bias2_rows(p);
        for (int rep = 0; rep < MK_REP_P3C; ++rep) phase3c(p, lds);
        __syncthreads();
    }
    STAMP(5);
    if (IN(5)) {
        for (int rep = 0; rep < MK_REP_RET; ++rep) for (int t = bx; t < 512; t += G) ret_task(p, lds, t);
        for (int rep = 0; rep < MK_EXTRA_SYNC; ++rep) xcd_barrier(xbar);
    }
    SEAM(5); STAMP(6);
    DBG(chk_p3(p));
    if (IN(6)) {
        pg8::Gemm g{DM, DM, DM, 256};
        SchedPlain<64, 4> S{(const char*)WSP(bf16, WS_YCAT), (const char*)WSP(bf16, WS_WOUTT), (size_t)256 * DM * 2, (size_t)256 * DM * 2, G, bx};
        EpiP4 E{p.x, WSP(bf16, WS_X1B), WSP(bf16, WS_A2), WSP(float, WS_MOD), p.norm2, WSP(float, WS_SUMSQ)};
        pg8::gemm_phase<EpiP4, SchedPlain<64, 4>>(lds, g, S, E);
        if (TILE_SYNC) tile_publish(WSP(unsigned, WS_CNT4) + 16 * tile_pm);
    }
    if (!TILE_SYNC) SEAM(6); STAMP(7);
    DBG(chk_p4(p));
    if (IN(7)) {
        if (TILE_SYNC) tile_wait(WSP(unsigned, WS_CNT4) + 16 * tile_pm, nullptr, nullptr, 4u);
        pg8::Gemm g{DM, DM, DM, 256};
        SchedPlain<64, 22> S{(const char*)WSP(bf16, WS_A2), (const char*)WSP(bf16, WS_WUPT), (size_t)256 * DM * 2, (size_t)256 * DM * 2, G, bx};
        EpiP5 E{WSP(bf16, WS_APRE), WSP(bf16, WS_HALO), WSP(float, WS_BIAS2), WSP(float, WS_SUMSQ), p.ffn_conv_w, p.ffn_conv_b};
        for (int rep = 0; rep < MK_REP_P5; ++rep) pg8::gemm_phase<EpiP5, SchedPlain<64, 22>, true, MK_P5_SP2>(lds, g, S, E);
        if (TILE_SYNC) tile_publish(WSP(unsigned, WS_CNT5) + 16 * tile_pm);
    }
    if (!TILE_SYNC) SEAM(7); STAMP(8);
    if (IN(8)) {
        pg8::Gemm g{DFF, DFF, DFF, 256};
        SchedPlain<64, 4> S{(const char*)WSP(bf16, WS_APRE), (const char*)WSP(bf16, WS_WDNT), (size_t)256 * DFF * 2, (size_t)256 * DFF * 2, G, bx};
        if (TILE_SYNC) { unsigned* c5 = WSP(unsigned, WS_CNT5);
            tile_wait(c5 + 16 * tile_pm, (tile_pm & 7) ? c5 + 16 * (tile_pm - 1) : nullptr, (tile_pm & 7) != 7 ? c5 + 16 * (tile_pm + 1) : nullptr, 4u); }
        { pg8::Unit u0; if (S.next(0, u0)) ffn_edge_rows(p, u0.pm); asm volatile("s_waitcnt vmcnt(0)" ::: "memory"); __syncthreads(); }
        EpiP7 E{p.out, WSP(bf16, WS_X1B), WSP(float, WS_MOD), p.norm_f, WSP(float, WS_XCH), WSP(unsigned, WS_CNT)};
        pg8::gemm_phase<EpiP7, SchedPlain<64, 4>>(lds, g, S, E);
    }
#if MK_TIMING
    xcd_barrier(xbar);
    if (bx == 0 && threadIdx.x == 0) { const unsigned long long* ts = WSP(unsigned long long, WS_TS); const unsigned long long tend = __builtin_amdgcn_s_memrealtime();
        const float da = (float)((MK_KA == 8 ? tend : ts[MK_KA + 1]) - ts[MK_KA]) * 0.01f, db = (float)((MK_KB == 8 ? tend : ts[MK_KB + 1]) - ts[MK_KB]) * 0.01f;
        const float qa = 8.f * floorf(da / 8.f + 0.5f), qb = 8.f * floorf(db / 8.f + 0.5f);
        p.out[0] = 100.f * qa; const int n = 100 * (int)qb; for (int i = 1; i <= n; ++i) p.out[i] = 1000.f; }
#endif
#if MK_DEBUG
    grid.sync(); chk_end(p, lds); grid.sync(); dbg_emit(p);
#endif
#undef IN
#undef SEAM
}

extern "C" void kernel_launch(void* const* d_in, const int* in_sizes, int n_in, void* d_out, int out_size, void* d_ws, size_t ws_size, hipStream_t stream) {
    static int grid = 0;
    if (grid == 0) {
        if (n_in != 27 || out_size != M_TOK * DM || ws_size < WS_END) { fprintf(stderr, "kernel_launch: unexpected shapes (n_in %d out %d ws %zu)\n", n_in, out_size, ws_size); grid = -1; return; }
        int dev = 0, cus = 0, per_cu = 0;
        if (hipGetDevice(&dev) != hipSuccess || hipDeviceGetAttribute(&cus, hipDeviceAttributeMultiprocessorCount, dev) != hipSuccess) { grid = -1; return; }
        if (hipFuncSetAttribute((const void*)fwd_kernel, hipFuncAttributeMaxDynamicSharedMemorySize, LDS_BYTES) != hipSuccess) { fprintf(stderr, "kernel_launch: hipFuncSetAttribute failed\n"); grid = -1; return; }
        if (hipOccupancyMaxActiveBlocksPerMultiprocessor(&per_cu, (const void*)fwd_kernel, 512, LDS_BYTES) != hipSuccess || per_cu < 1) { fprintf(stderr, "kernel_launch: occupancy query says %d\n", per_cu); per_cu = 1; }
        (void)hipGetLastError();
        grid = cus * 1;
        fprintf(stderr, "kernel_launch: grid %d (cus %d, per_cu %d)\n", grid, cus, per_cu);
    }
    if (grid < 0) return;
    Params p{};
    const float** pp = (const float**)&p;
    for (int i = 0; i < 27; ++i) pp[i] = (const float*)d_in[i];
    p.out = (float*)d_out; p.ws = (unsigned char*)d_ws;
#if MK_MULTI
    for (int k = 0; k < N_PHASES; ++k) { p.ph_lo = k; p.ph_hi = k + 1; void* args[] = {&p};
        hipError_t e = hipLaunchCooperativeKernel((const void*)fwd_kernel, dim3(grid), dim3(512), args, LDS_BYTES, stream);
        if (e != hipSuccess) { fprintf(stderr, "kernel_launch: launch %d failed: %s\n", k, hipGetErrorString(e)); break; } }
#else
    for (int pass = 0; pass < MK_PASSES; ++pass) {
    if (hipMemsetAsync((char*)d_ws + WS_BAR, 0, WS_ZERO_BYTES, stream) != hipSuccess) { fprintf(stderr, "kernel_launch: memset failed\n"); return; }
    p.ph_lo = 0; p.ph_hi = N_PHASES; void* args[] = {&p};
    hipError_t e = hipLaunchCooperativeKernel((const void*)fwd_kernel, dim3(grid), dim3(512), args, LDS_BYTES, stream);
    if (e != hipSuccess) fprintf(stderr, "kernel_launch: cooperative launch failed: %s (grid %d)\n", hipGetErrorString(e), grid);
    }
#endif
}
```
